# Optimizing an MI355X kernel written in HIP

```python
import jax, jax.numpy as jnp
from jax import lax
import numpy as np

D_MODEL = 1024
BATCH = 8
SEQ = 8192
DEPTH = 2
DEC_BATCH = 8
DEC_SEQ = 4096
PAST_LEN = 128

MLA_HEADS = 16
Q_LORA = 256
KV_LORA = 128
QK_NOPE = 64
QK_ROPE = 32
V_DIM = 64
ROPE_THETA = 10000.0
Q_BLOCK = 128
NA_HEADS = 16
NA_HEAD_DIM = D_MODEL // NA_HEADS
GRID_W = 64
WIN_R = 8
WIN_C = 16
FFN_HIDDEN = -(-8 * D_MODEL // (3 * 256)) * 256
N_MLA = (DEPTH + 1) // 2
N_NA = DEPTH // 2
N_MOD = 6
RMS_EPS = 1e-6
NEG_INF = -1e30

kernel_name = 'hybrid_mla_natten_encoder'


def _rmsnorm(x, g):
    xf = x.astype(jnp.float32)
    y = xf * lax.rsqrt(jnp.mean(xf * xf, axis=-1, keepdims=True) + RMS_EPS)
    return (y * g.astype(jnp.float32)).astype(x.dtype)


def _rope_tables(seq_len):
    inv_freq = 1.0 / (ROPE_THETA ** (jnp.arange(0, QK_ROPE, 2, dtype=jnp.float32) / QK_ROPE))
    ang = jnp.arange(seq_len, dtype=jnp.float32)[:, None] * inv_freq[None, :]
    return jnp.cos(ang), jnp.sin(ang)


def _apply_rope(x, cos, sin):
    cos = cos.astype(x.dtype)
    sin = sin.astype(x.dtype)
    x1, x2 = jnp.split(x, 2, axis=-1)
    return jnp.concatenate([x1 * cos - x2 * sin, x2 * cos + x1 * sin], axis=-1)


def _mla(h, w_dkv, q_norm, kv_norm, w_uq, w_ukv, w_o):
    B, S, _ = h.shape
    lat = h @ w_dkv
    cq = _rmsnorm(lat[..., :Q_LORA], q_norm)
    ckv = _rmsnorm(lat[..., Q_LORA:Q_LORA + KV_LORA], kv_norm)
    k_rope = lat[..., Q_LORA + KV_LORA:]
    q = (cq @ w_uq).reshape(B, S, MLA_HEADS, QK_NOPE + QK_ROPE)
    kv = (ckv @ w_ukv).reshape(B, S, MLA_HEADS, QK_NOPE + V_DIM)
    k_nope, v = kv[..., :QK_NOPE], kv[..., QK_NOPE:]
    cos, sin = _rope_tables(S)
    scale = (QK_NOPE + QK_ROPE) ** -0.5
    q_nope = q[..., :QK_NOPE] * scale
    q_rope = _apply_rope(q[..., QK_NOPE:], cos[:, None, :], sin[:, None, :]) * scale
    k_rope = _apply_rope(k_rope, cos, sin)
    nb = S // Q_BLOCK
    qn = q_nope.reshape(B, nb, Q_BLOCK, MLA_HEADS, QK_NOPE).transpose(1, 0, 2, 3, 4)
    qr = q_rope.reshape(B, nb, Q_BLOCK, MLA_HEADS, QK_ROPE).transpose(1, 0, 2, 3, 4)

    def attend(blk):
        qn_b, qr_b = blk
        s = (jnp.einsum('bqhd,bkhd->bhqk', qn_b, k_nope, preferred_element_type=jnp.float32)
             + jnp.einsum('bqhr,bkr->bhqk', qr_b, k_rope, preferred_element_type=jnp.float32))
        p = jax.nn.softmax(s, axis=-1).astype(v.dtype)
        return jnp.einsum('bhqk,bkhd->bqhd', p, v)

    o = lax.map(attend, (qn, qr))
    o = o.transpose(1, 0, 2, 3, 4).reshape(B, S, MLA_HEADS * V_DIM)
    return o @ w_o


def _neighbourhood_attention(h, w_qkv, rpb, w_o):
    B, S, _ = h.shape
    rows = S // GRID_W
    win_r = min(WIN_R, rows)
    qkv = (h @ w_qkv).reshape(B, rows, GRID_W, 3, NA_HEADS, NA_HEAD_DIM)
    q = qkv[:, :, :, 0] * (NA_HEAD_DIM ** -0.5)
    k = qkv[:, :, :, 1]
    v = qkv[:, :, :, 2]
    c_idx = jnp.arange(GRID_W)
    c_start = jnp.clip(c_idx - WIN_C // 2, 0, GRID_W - WIN_C)
    col_valid = (c_idx[None, :] >= c_start[:, None]) & (c_idx[None, :] < c_start[:, None] + WIN_C)
    dc_idx = jnp.clip(c_idx[None, :] - c_idx[:, None] + WIN_C - 1, 0, 2 * WIN_C - 2)
    col_bias = rpb.astype(jnp.float32)[:, :, dc_idx]
    col_bias = jnp.where(col_valid[None, None], col_bias, NEG_INF)

    def row_block(r):
        r_start = jnp.clip(r - win_r // 2, 0, rows - win_r)
        q_r = lax.dynamic_index_in_dim(q, r, axis=1, keepdims=False)
        k_band = lax.dynamic_slice_in_dim(k, r_start, win_r, axis=1)
        v_band = lax.dynamic_slice_in_dim(v, r_start, win_r, axis=1)
        dr_idx = r_start + jnp.arange(win_r) - r + WIN_R - 1
        bias = col_bias[:, dr_idx].transpose(0, 2, 1, 3)
        s = jnp.einsum('bqhd,bjkhd->bhqjk', q_r, k_band, preferred_element_type=jnp.float32) + bias[None]
        p = jax.nn.softmax(s.reshape(B, NA_HEADS, GRID_W, win_r * GRID_W), axis=-1)
        p = p.reshape(B, NA_HEADS, GRID_W, win_r, GRID_W).astype(v.dtype)
        return jnp.einsum('bhqjk,bjkhd->bqhd', p, v_band)

    o = lax.map(row_block, jnp.arange(rows, dtype=jnp.int32))
    o = o.transpose(1, 0, 2, 3, 4).reshape(B, S, NA_HEADS * NA_HEAD_DIM)
    return o @ w_o


def _swiglu(h, w_gu, w_down):
    gu = h @ w_gu
    g, u = gu[..., :FFN_HIDDEN], gu[..., FFN_HIDDEN:]
    return (jax.nn.silu(g) * u) @ w_down


def _trunk(x, c, ada_w, ada_b, norm_pre_mix, norm_post_mix, norm_pre_ffn, norm_post_ffn,
           mla_w_dkv, mla_q_norm, mla_kv_norm, mla_w_uq, mla_w_ukv, mla_w_o,
           na_w_qkv, na_rpb, na_w_o, ffn_w_gu, ffn_w_down):
    B = x.shape[0]
    c_act = jax.nn.silu(c)
    for i in range(DEPTH):
        mod = (c_act @ ada_w[i] + ada_b[i]).astype(x.dtype).reshape(B, N_MOD, 1, D_MODEL)
        shift_m, scale_m, gate_m = mod[:, 0], mod[:, 1], mod[:, 2]
        shift_f, scale_f, gate_f = mod[:, 3], mod[:, 4], mod[:, 5]
        h = _rmsnorm(x, norm_pre_mix[i]) * (1 + scale_m) + shift_m
        j = i // 2
        if i % 2 == 0:
            h = _mla(h, mla_w_dkv[j], mla_q_norm[j], mla_kv_norm[j], mla_w_uq[j], mla_w_ukv[j], mla_w_o[j])
        else:
            h = _neighbourhood_attention(h, na_w_qkv[j], na_rpb[j], na_w_o[j])
        x = x + gate_m * _rmsnorm(h, norm_post_mix[i])
        h = _rmsnorm(x, norm_pre_ffn[i]) * (1 + scale_f) + shift_f
        h = _swiglu(h, ffn_w_gu[i], ffn_w_down[i])
        x = x + gate_f * _rmsnorm(h, norm_post_ffn[i])
    return x


def _w(k, shape, fan_in, gain=1.0):
    return (gain * fan_in ** -0.5) * jax.random.normal(k, shape, dtype=jnp.float32)


def _gain(k, shape):
    return 1.0 + 0.05 * jax.random.normal(k, shape, dtype=jnp.float32)


def setup_inputs(seed: int = 0) -> dict:
    key = jax.random.key(seed)
    ks = jax.random.split(key, 24)
    D = D_MODEL
    return {
        'x_prompt': jax.random.normal(ks[0], (BATCH, SEQ, D), dtype=jnp.float32),
        'x_sample': jax.random.normal(ks[1], (DEC_BATCH, DEC_SEQ, D), dtype=jnp.float32),
        'c_prompt': jax.random.normal(ks[2], (BATCH, D), dtype=jnp.float32),
        'c_sample': jax.random.normal(ks[3], (DEC_BATCH, D), dtype=jnp.float32),
        'ada_w': _w(ks[4], (DEPTH, D, N_MOD * D), D, 0.5),
        'ada_b': 0.02 * jax.random.normal(ks[5], (DEPTH, N_MOD * D), dtype=jnp.float32),
        'norm_pre_mix': _gain(ks[6], (DEPTH, D)),
        'norm_post_mix': _gain(ks[7], (DEPTH, D)),
        'norm_pre_ffn': _gain(ks[8], (DEPTH, D)),
        'norm_post_ffn': _gain(ks[9], (DEPTH, D)),
        'mla_w_dkv': _w(ks[10], (N_MLA, D, Q_LORA + KV_LORA + QK_ROPE), D),
        'mla_q_norm': _gain(ks[11], (N_MLA, Q_LORA)),
        'mla_kv_norm': _gain(ks[12], (N_MLA, KV_LORA)),
        'mla_w_uq': _w(ks[13], (N_MLA, Q_LORA, MLA_HEADS * (QK_NOPE + QK_ROPE)), Q_LORA),
        'mla_w_ukv': _w(ks[14], (N_MLA, KV_LORA, MLA_HEADS * (QK_NOPE + V_DIM)), KV_LORA),
        'mla_w_o': _w(ks[15], (N_MLA, MLA_HEADS * V_DIM, D), MLA_HEADS * V_DIM),
        'na_w_qkv': _w(ks[16], (N_NA, D, 3 * NA_HEADS * NA_HEAD_DIM), D),
        'na_rpb': 0.1 * jax.random.normal(ks[17], (N_NA, NA_HEADS, 2 * WIN_R - 1, 2 * WIN_C - 1), dtype=jnp.float32),
        'na_w_o': _w(ks[18], (N_NA, NA_HEADS * NA_HEAD_DIM, D), NA_HEADS * NA_HEAD_DIM),
        'ffn_w_gu': _w(ks[19], (DEPTH, D, 2 * FFN_HIDDEN), D),
        'ffn_w_down': _w(ks[20], (DEPTH, FFN_HIDDEN, D), FFN_HIDDEN),
    }


def reference(x_prompt, x_sample, c_prompt, c_sample, ada_w, ada_b, norm_pre_mix, norm_post_mix,
              norm_pre_ffn, norm_post_ffn, mla_w_dkv, mla_q_norm, mla_kv_norm, mla_w_uq, mla_w_ukv,
              mla_w_o, na_w_qkv, na_rpb, na_w_o, ffn_w_gu, ffn_w_down):
    y_prompt = _trunk(x_prompt, c_prompt, ada_w, ada_b, norm_pre_mix, norm_post_mix, norm_pre_ffn,
                      norm_post_ffn, mla_w_dkv, mla_q_norm, mla_kv_norm, mla_w_uq, mla_w_ukv, mla_w_o,
                      na_w_qkv, na_rpb, na_w_o, ffn_w_gu, ffn_w_down)
    y_sample = _trunk(x_sample, c_sample, ada_w, ada_b, norm_pre_mix, norm_post_mix, norm_pre_ffn,
                      norm_post_ffn, mla_w_dkv, mla_q_norm, mla_kv_norm, mla_w_uq, mla_w_ukv, mla_w_o,
                      na_w_qkv, na_rpb, na_w_o, ffn_w_gu, ffn_w_down)
    return (y_prompt, y_sample)
```

```cpp
#include <hip/hip_runtime.h>
#include <hip/hip_cooperative_groups.h>
#include <cstdio>
#include <cstdint>
namespace cg = cooperative_groups;

#ifndef PH_MASK
#define PH_MASK 0xFFFFF
#endif
#define PH_ON(k) ((PH_MASK >> (k)) & 1)
#ifndef REP_MASK
#define REP_MASK 0
#endif
#ifndef EXTRA_SYNC
#define EXTRA_SYNC 0
#endif
#ifndef MK_MULTI
#define MK_MULTI 0
#endif

#define LAS __attribute__((address_space(3)))
typedef unsigned short bf16_t;
typedef short bf16x8 __attribute__((ext_vector_type(8)));
typedef short s16x4 __attribute__((ext_vector_type(4)));
typedef float f32x2 __attribute__((ext_vector_type(2)));
typedef float f32x4 __attribute__((ext_vector_type(4)));
typedef float f32x16 __attribute__((ext_vector_type(16)));
typedef unsigned u32x2 __attribute__((ext_vector_type(2)));
typedef unsigned u32x4 __attribute__((ext_vector_type(4)));

constexpr int DM = 1024, TP = 65536, T = 98304, FF = 2816;
constexpr int NQ = 1536, NKV = 2048, NLAT = 512;
constexpr float RMS_EPS = 1e-6f;
constexpr float LOG2E = 1.4426950408889634f;
constexpr float QSCALE_MLA = 0.10206207261596577f * LOG2E;
constexpr float QSCALE_NA = 0.125f * LOG2E;

constexpr size_t MiB = 1u << 20;
constexpr size_t WS_WDKV = 0, WS_WUQ = 1 * MiB, WS_WUKV = 2 * MiB, WS_WO = 3 * MiB, WS_NAQKV = 5 * MiB, WS_NAO = 11 * MiB,
                 WS_WGU = 13 * MiB  , WS_WDN = 35 * MiB  , WS_MOD = 46 * MiB, WS_ROPE = 47 * MiB;
constexpr size_t WS_BAR = 48 * MiB, BAR_BYTES = 16384;
constexpr size_t WS_HN = 64 * MiB;
constexpr size_t WS_R1 = 256 * MiB;
constexpr size_t WS_HID = 448 * MiB;
constexpr size_t WS_Q = 640 * MiB;
constexpr size_t WS_KR = 928 * MiB;
constexpr size_t WS_CQ = 934 * MiB;
constexpr size_t WS_CKV = 982 * MiB;
constexpr size_t WS_END = 1006 * MiB;
constexpr int LDS_ST_OFF = 163840 - 64;
constexpr int LDS_BYTES = 163840;

__device__ __forceinline__ unsigned cvt_pk_bf16(float lo, float hi) { unsigned r; asm("v_cvt_pk_bf16_f32 %0, %1, %2" : "=v"(r) : "v"(lo), "v"(hi)); return r; }
__device__ __forceinline__ bf16_t f2bf(float x) { return (bf16_t)(cvt_pk_bf16(x, x) & 0xffffu); }
__device__ __forceinline__ float bf_lo(unsigned u) { return __uint_as_float(u << 16); }
__device__ __forceinline__ float bf_hi(unsigned u) { return __uint_as_float(u & 0xffff0000u); }
__device__ __forceinline__ float wave_sum(float v) {
#pragma unroll
    for (int o = 1; o < 64; o <<= 1) v += __shfl_xor(v, o);
    return v;
}
__device__ __forceinline__ int tok_pos(int t) { return t < TP ? (t & 8191) : (t & 4095); }
__device__ __forceinline__ int tok_bb(int t) { return t < TP ? (t >> 13) : 8 + ((t - TP) >> 12); }

namespace pg8 {
constexpr int BM = 256, BK = 64, HALF = 128, HTB = HALF * BK * 2, NXCD = 8, WGM = 8;
__host__ __device__ __forceinline__ int lds_byte(int r, int c) { const int st = (r >> 4) * 2 + (c >> 5), rr = r & 15, cc = c & 31, ob = rr * 64 + cc * 2; return st * 1024 + (ob ^ (((ob >> 9) & 1) << 5)); }
__host__ __device__ __forceinline__ void stage_rc(int b, int& R, int& C) { const int st = b / 1024, sb = b % 1024, swz = sb ^ (((sb >> 9) & 1) << 5); R = (st >> 1) * 16 + swz / 64; C = (st & 1) * 32 + (swz % 64) / 2; }
__host__ __device__ __forceinline__ int perm32(int rho) { const int n = rho >> 4, i = rho & 15; return 8 * (i >> 2) + 4 * n + (i & 3); }

struct Unit { int pm, pn; };
struct Gemm { const bf16_t* A; const bf16_t* Bt; int M, N, K; };

struct StaticOrder {
    int nM, nN, nwg, G, c;
    __device__ void init(int M, int N, int G_, int c_) { nM = M / BM; nN = N / BM; nwg = nM * nN; G = G_; c = c_; }
    __device__ bool next(int i, Unit& u) const {
        const long L = (long)i * G + c; if (L >= nwg) return false;
        int wgid = (int)L; { const int q = nwg / NXCD, r = nwg % NXCD, xcd = wgid % NXCD, off = wgid / NXCD; wgid = (xcd < r ? xcd * (q + 1) : r * (q + 1) + (xcd - r) * q) + off; }
        const int nig = WGM * nN, gid = wgid / nig, fm = gid * WGM, gsz = (nM - fm) < WGM ? (nM - fm) : WGM;
        u.pm = fm + ((wgid % nig) % gsz); u.pn = (wgid % nig) / gsz; return true;
    }
};


struct EpiF32 {
    static constexpr bool PERM = false;
    float* O; int ldc;
    __device__ __forceinline__ void operator()(const f32x4 (&acc)[2][2][4][2], const Unit& u, int wr, int wc, int fr, int fq) const {
        const int row0 = u.pm * BM + wr * 64 + fr, col0 = u.pn * BM + wc * 32 + 4 * fq;
#pragma unroll
        for (int ai = 0; ai < 2; ++ai)
#pragma unroll
            for (int m = 0; m < 4; ++m) { float* rowp = O + (size_t)(row0 + ai * HALF + m * 16) * ldc + col0;
#pragma unroll
                for (int bj = 0; bj < 2; ++bj)
#pragma unroll
                    for (int n = 0; n < 2; ++n) *(f32x4*)(rowp + bj * HALF + n * 16) = acc[ai][bj][m][n]; }
    }
};
struct EpiLat {
    static constexpr bool PERM = false;
    bf16_t* CQ; bf16_t* CKV; bf16_t* KR; const float* qn; const float* kvn; const f32x2* rope; LAS float* xch;
    __device__ __forceinline__ void operator()(const f32x4 (&acc)[2][2][4][2], const Unit& u, int wr, int wc, int fr, int fq) const {
        const bool is_q = (u.pn == 0);
        LAS float* xw = xch + ((wr * 64 + fr) * 16 + wc * 4 + fq); const LAS float* xr = xch + (wr * 64 + fr) * 16;
#pragma unroll
        for (int ai = 0; ai < 2; ++ai)
#pragma unroll
            for (int m = 0; m < 4; ++m) { float sq = 0.f;
#pragma unroll
                for (int n = 0; n < 2; ++n) { const f32x4 x = acc[ai][0][m][n]; sq += (x[0] * x[0] + x[1] * x[1]) + (x[2] * x[2] + x[3] * x[3]); }
                if (is_q) {
#pragma unroll
                    for (int n = 0; n < 2; ++n) { const f32x4 x = acc[ai][1][m][n]; sq += (x[0] * x[0] + x[1] * x[1]) + (x[2] * x[2] + x[3] * x[3]); } }
                xw[(ai * HALF + m * 16) * 16] = sq; }
        asm volatile("s_waitcnt lgkmcnt(0)\n\ts_barrier" ::: "memory");
        const int col0 = wc * 32 + 4 * fq;
        if (is_q) {
#pragma unroll
            for (int ai = 0; ai < 2; ++ai)
#pragma unroll
                for (int m = 0; m < 4; ++m) { const int rl = ai * HALF + wr * 64 + m * 16 + fr; bf16_t* op = CQ + ((size_t)u.pm * BM + rl) * 256 + col0;
                    float tot = 0.f;
#pragma unroll
                    for (int q4 = 0; q4 < 4; ++q4) { const f32x4 pr = *(const LAS f32x4*)(xr + (ai * HALF + m * 16) * 16 + q4 * 4); tot += (pr[0] + pr[1]) + (pr[2] + pr[3]); }
                    const float rstd = __builtin_amdgcn_rsqf(tot * (1.f / 256.f) + RMS_EPS);
#pragma unroll
                    for (int bj = 0; bj < 2; ++bj)
#pragma unroll
                        for (int n = 0; n < 2; ++n) { const f32x4 g = *(const f32x4*)(qn + bj * HALF + col0 + n * 16); const f32x4 v = acc[ai][bj][m][n] * rstd * g;
                            u32x2 w; w.x = cvt_pk_bf16(v[0], v[1]); w.y = cvt_pk_bf16(v[2], v[3]); *(u32x2*)(op + bj * HALF + n * 16) = w; }
                    asm volatile("" ::: "memory"); }
        } else {
#pragma unroll
            for (int ai = 0; ai < 2; ++ai)
#pragma unroll
                for (int m = 0; m < 4; ++m) { const int rl = ai * HALF + wr * 64 + m * 16 + fr; const size_t row = (size_t)u.pm * BM + rl;
                    float tot = 0.f;
#pragma unroll
                    for (int q4 = 0; q4 < 4; ++q4) { const f32x4 pr = *(const LAS f32x4*)(xr + (ai * HALF + m * 16) * 16 + q4 * 4); tot += (pr[0] + pr[1]) + (pr[2] + pr[3]); }
                    const float rstd = __builtin_amdgcn_rsqf(tot * (1.f / 128.f) + RMS_EPS);
#pragma unroll
                    for (int n = 0; n < 2; ++n) { const f32x4 g = *(const f32x4*)(kvn + col0 + n * 16); const f32x4 v = acc[ai][0][m][n] * rstd * g;
                        u32x2 w; w.x = cvt_pk_bf16(v[0], v[1]); w.y = cvt_pk_bf16(v[2], v[3]); *(u32x2*)(CKV + row * 128 + col0 + n * 16) = w; }
                    if (wc == 0) { const f32x4* rp = (const f32x4*)(rope + (size_t)tok_pos((int)row) * 16 + 4 * fq); const f32x4 cs0 = rp[0], cs1 = rp[1];
                        const f32x4 c = {cs0[0], cs0[2], cs1[0], cs1[2]}, sn = {cs0[1], cs0[3], cs1[1], cs1[3]};
                        const f32x4 x1 = acc[ai][1][m][0], x2 = acc[ai][1][m][1]; const f32x4 o1 = x1 * c - x2 * sn, o2 = x2 * c + x1 * sn;
                        u32x2 w1, w2; w1.x = cvt_pk_bf16(o1[0], o1[1]); w1.y = cvt_pk_bf16(o1[2], o1[3]); w2.x = cvt_pk_bf16(o2[0], o2[1]); w2.y = cvt_pk_bf16(o2[2], o2[3]);
                        *(u32x2*)(KR + row * 32 + 4 * fq) = w1; *(u32x2*)(KR + row * 32 + 16 + 4 * fq) = w2; }
                    asm volatile("" ::: "memory"); }
        }
        asm volatile("s_waitcnt lgkmcnt(0)\n\ts_barrier" ::: "memory");
    }
};
struct EpiBf16S {
    static constexpr bool PERM = true;
    bf16_t* O; int ldc; int scale_cols; float scale0;
    __device__ __forceinline__ void operator()(const f32x4 (&acc)[2][2][4][2], const Unit& u, int wr, int wc, int fr, int fq) const {
        const int row0 = u.pm * BM + wr * 64 + fr, col0 = u.pn * BM + wc * 32 + 8 * fq;
        const float sc = (u.pn * BM < scale_cols) ? scale0 : 1.f;
#pragma unroll
        for (int ai = 0; ai < 2; ++ai)
#pragma unroll
            for (int m = 0; m < 4; ++m) { bf16_t* rowp = O + (size_t)(row0 + ai * HALF + m * 16) * ldc + col0;
#pragma unroll
                for (int bj = 0; bj < 2; ++bj) { const f32x4 v0 = acc[ai][bj][m][0] * sc, v1 = acc[ai][bj][m][1] * sc;
                    u32x4 w; w.x = cvt_pk_bf16(v0[0], v0[1]); w.y = cvt_pk_bf16(v0[2], v0[3]); w.z = cvt_pk_bf16(v1[0], v1[1]); w.w = cvt_pk_bf16(v1[2], v1[3]);
                    *(u32x4*)(rowp + bj * HALF) = w; } }
    }
};
struct EpiSwiGLU {
    static constexpr bool PERM = true;
    bf16_t* O;
    __device__ __forceinline__ void operator()(const f32x4 (&acc)[2][2][4][2], const Unit& u, int wr, int wc, int fr, int fq) const {
        const int row0 = u.pm * BM + wr * 64 + fr, col0 = u.pn * HALF + wc * 32 + 8 * fq;
#pragma unroll
        for (int ai = 0; ai < 2; ++ai)
#pragma unroll
            for (int m = 0; m < 4; ++m) { bf16_t* rowp = O + (size_t)(row0 + ai * HALF + m * 16) * FF + col0;
                float v[8];
#pragma unroll
                for (int n = 0; n < 2; ++n)
#pragma unroll
                    for (int i = 0; i < 4; ++i) { const float g = acc[ai][0][m][n][i], up = acc[ai][1][m][n][i];
                        v[n * 4 + i] = g * __builtin_amdgcn_rcpf(1.f + __builtin_amdgcn_exp2f(-g * LOG2E)) * up; }
                u32x4 w; w.x = cvt_pk_bf16(v[0], v[1]); w.y = cvt_pk_bf16(v[2], v[3]); w.z = cvt_pk_bf16(v[4], v[5]); w.w = cvt_pk_bf16(v[6], v[7]);
                *(u32x4*)rowp = w; }
    }
};

template <class Epi>
__device__ __forceinline__ void gemm_phase(LAS unsigned char* lds, const Gemm g, const StaticOrder& S, const Epi& E, const int tid) {
    const int wid = __builtin_amdgcn_readfirstlane(tid >> 6), lane = tid & 63, wr = wid >> 2, wc = wid & 3, fr = lane & 15, fq = lane >> 4;
    const int K = g.K, nt = K / BK;
    unsigned voffA[2], voffB[2];
#pragma unroll
    for (int i = 0; i < 2; ++i) { int R, C; stage_rc(tid * 16 + i * 8192, R, C); const int Rb = Epi::PERM ? ((R & ~31) + perm32(R & 31)) : R;
        voffA[i] = (unsigned)(R * K + C) * 2u; voffB[i] = (unsigned)(Rb * K + C) * 2u; }
    const size_t kstep = (size_t)(BK * 2);
    const size_t hstep = (size_t)HALF * K * 2;
    const size_t tstep = 2 * hstep;
    const unsigned ldsw = (unsigned)wid * 1024u;
    const int aoff = lds_byte(wr * 64 + fr, fq * 8), boff = lds_byte(wc * 32 + fr, fq * 8);
#define PG8_SA(b, h) (((b) * 2 + (h)) * HTB)
#define PG8_SB(b, h) ((4 + (b) * 2 + (h)) * HTB)
#define PG8_STAGE(bufoff, gbase, voff) do { _Pragma("unroll") for (int _i = 0; _i < 2; ++_i) \
        __builtin_amdgcn_global_load_lds((const unsigned*)((const char*)(gbase) + (voff)[_i]), (LAS unsigned*)(lds + (bufoff) + ldsw + _i * 8192), 16, 0, 0); } while (0)
#define PG8_LDA(dst, b, h) do { _Pragma("unroll") for (int m = 0; m < 4; ++m) _Pragma("unroll") for (int k = 0; k < 2; ++k) dst[m][k] = *(const LAS bf16x8*)(lds + PG8_SA(b, h) + aoff + m * 2048 + k * 1024); } while (0)
#define PG8_LDB(dst, b, h) do { _Pragma("unroll") for (int n = 0; n < 2; ++n) _Pragma("unroll") for (int k = 0; k < 2; ++k) dst[n][k] = *(const LAS bf16x8*)(lds + PG8_SB(b, h) + boff + n * 2048 + k * 1024); } while (0)
#define PG8_MMA(ai, bj, At, Bt) do { __builtin_amdgcn_s_setprio(1); _Pragma("unroll") for (int m = 0; m < 4; ++m) _Pragma("unroll") for (int n = 0; n < 2; ++n) _Pragma("unroll") for (int k = 0; k < 2; ++k) \
        acc[ai][bj][m][n] = __builtin_amdgcn_mfma_f32_16x16x32_bf16(Bt[n][k], At[m][k], acc[ai][bj][m][n], 0, 0, 0); __builtin_amdgcn_s_setprio(0); } while (0)
#define PG8_WAIT_V(n) asm volatile("s_waitcnt vmcnt(" #n ")" ::: "memory")
#define PG8_WAIT_L(n) asm volatile("s_waitcnt lgkmcnt(" #n ")" ::: "memory")
#define PG8_BAR __builtin_amdgcn_s_barrier()
#define PG8_SCHED __builtin_amdgcn_sched_barrier(0)
    Unit cur, nxt; int ui = 0;
    if (!S.next(0, cur)) return;
    f32x4 acc[2][2][4][2];
#pragma unroll
    for (int a = 0; a < 2; ++a)
#pragma unroll
        for (int b = 0; b < 2; ++b)
#pragma unroll
            for (int m = 0; m < 4; ++m)
#pragma unroll
                for (int n = 0; n < 2; ++n) acc[a][b][m][n] = (f32x4){0.f, 0.f, 0.f, 0.f};
    bf16x8 At[4][2], B0[2][2], B1[2][2];
    const char* cA = (const char*)g.A + (size_t)cur.pm * tstep; const char* cB = (const char*)g.Bt + (size_t)cur.pn * tstep;
    PG8_STAGE(PG8_SB(0, 0), cB, voffB); PG8_STAGE(PG8_SB(0, 1), cB + hstep, voffB); PG8_STAGE(PG8_SA(0, 0), cA, voffA); PG8_STAGE(PG8_SA(0, 1), cA + hstep, voffA);
    if (wr == 1) PG8_BAR;
    PG8_WAIT_V(2); PG8_BAR;
    PG8_STAGE(PG8_SB(1, 0), cB + kstep, voffB); PG8_STAGE(PG8_SA(1, 0), cA + kstep, voffA); PG8_STAGE(PG8_SB(1, 1), cB + hstep + kstep, voffB);
    PG8_WAIT_V(6); PG8_BAR;
    for (;;) {
        const bool has_next = S.next(ui + 1, nxt);
        const char* nA = has_next ? (const char*)g.A + (size_t)nxt.pm * tstep : cA; const char* nB = has_next ? (const char*)g.Bt + (size_t)nxt.pn * tstep : cB;
        for (int t = 0; t < nt; t += 2) {
            const bool last = (t == nt - 2);
            const char* a1 = cA + (size_t)(t + 1) * kstep;
            const char* a2 = last ? nA : cA + (size_t)(t + 2) * kstep; const char* b2 = last ? nB : cB + (size_t)(t + 2) * kstep;
            const char* a3 = a2 + kstep; const char* b3 = b2 + kstep;
            PG8_LDB(B0, 0, 0); PG8_LDB(B1, 0, 1); PG8_SCHED; PG8_LDA(At, 0, 0); PG8_STAGE(PG8_SA(1, 1), a1 + hstep, voffA);
            PG8_WAIT_V(8); PG8_WAIT_L(0); PG8_BAR; PG8_MMA(0, 0, At, B0); PG8_MMA(0, 1, At, B1); PG8_BAR; PG8_SCHED;
            PG8_LDA(At, 0, 1); PG8_STAGE(PG8_SB(0, 0), b2, voffB); PG8_STAGE(PG8_SB(0, 1), b2 + hstep, voffB); PG8_STAGE(PG8_SA(0, 0), a2, voffA);
            PG8_WAIT_V(8); PG8_WAIT_L(0); PG8_BAR; PG8_MMA(1, 0, At, B0); PG8_MMA(1, 1, At, B1); PG8_BAR; PG8_SCHED;
            PG8_LDB(B0, 1, 0); PG8_LDB(B1, 1, 1); PG8_SCHED; PG8_LDA(At, 1, 0); PG8_STAGE(PG8_SA(0, 1), a2 + hstep, voffA);
            PG8_WAIT_V(8); PG8_WAIT_L(0); PG8_BAR; PG8_MMA(0, 0, At, B0); PG8_MMA(0, 1, At, B1); PG8_BAR; PG8_SCHED;
            PG8_LDA(At, 1, 1); PG8_STAGE(PG8_SB(1, 0), b3, voffB); PG8_STAGE(PG8_SB(1, 1), b3 + hstep, voffB); PG8_STAGE(PG8_SA(1, 0), a3, voffA);
            PG8_WAIT_V(8); PG8_WAIT_L(0); PG8_BAR; PG8_MMA(1, 0, At, B0); PG8_MMA(1, 1, At, B1); PG8_BAR; PG8_SCHED;
        }
        if (wr == 0) PG8_BAR;
        E(acc, cur, wr, wc, fr, fq);
        if (!has_next) break;
#pragma unroll
        for (int a = 0; a < 2; ++a)
#pragma unroll
            for (int b = 0; b < 2; ++b)
#pragma unroll
                for (int m = 0; m < 4; ++m)
#pragma unroll
                    for (int n = 0; n < 2; ++n) acc[a][b][m][n] = (f32x4){0.f, 0.f, 0.f, 0.f};
        cur = nxt; cA = nA; cB = nB; ++ui;
        if (wr == 1) PG8_BAR;
    }
    PG8_WAIT_V(0);
    PG8_BAR;
#undef PG8_SA
#undef PG8_SB
#undef PG8_STAGE
#undef PG8_LDA
#undef PG8_LDB
#undef PG8_MMA
#undef PG8_WAIT_V
#undef PG8_WAIT_L
#undef PG8_BAR
#undef PG8_SCHED
}
}

#define SBAR() __builtin_amdgcn_sched_barrier(0)
#define KSWZ(row, colB) ((row) * 256 + ((colB) ^ (((row) & 7) << 4)))
__device__ __forceinline__ int crow(int r, int hi) { return (r & 3) + 8 * (r >> 2) + 4 * hi; }
constexpr float SM_THR = 8.f;

__device__ __forceinline__ void partialSM(f32x16& p0, f32x16& p1, float& m_reg, float& mn, float& alpha) {
    float pmax = p0[0];
#pragma unroll
    for (int r = 1; r < 16; ++r) pmax = fmaxf(pmax, p0[r]);
#pragma unroll
    for (int r = 0; r < 16; ++r) pmax = fmaxf(pmax, p1[r]);
    { auto rr = __builtin_amdgcn_permlane32_swap(__float_as_uint(pmax), __float_as_uint(pmax), false, false);
      pmax = fmaxf(__uint_as_float(rr[0]), __uint_as_float(rr[1])); }
    if (__builtin_expect(__all(pmax - m_reg <= SM_THR), 1)) { mn = m_reg; alpha = 1.f; }
    else { mn = fmaxf(m_reg, pmax); alpha = __builtin_amdgcn_exp2f(m_reg - mn); m_reg = mn; }
#pragma unroll
    for (int r = 0; r < 16; ++r) p0[r] -= mn;
#pragma unroll
    for (int r = 0; r < 16; ++r) p1[r] -= mn;
#pragma unroll
    for (int r = 0; r < 16; ++r) p0[r] = __builtin_amdgcn_exp2f(p0[r]);
}
__device__ __forceinline__ void finishSM(f32x16& p0, f32x16& p1, float alpha, float& l_reg, bf16x8& pa0, bf16x8& pa1, bf16x8& pa2, bf16x8& pa3) {
#pragma unroll
    for (int r = 0; r < 16; ++r) p1[r] = __builtin_amdgcn_exp2f(p1[r]);
    float ps = 0;
#pragma unroll
    for (int r = 0; r < 16; ++r) ps += p0[r];
#pragma unroll
    for (int r = 0; r < 16; ++r) ps += p1[r];
    { auto rr = __builtin_amdgcn_permlane32_swap(__float_as_uint(ps), __float_as_uint(ps), false, false);
      ps = __uint_as_float(rr[0]) + __uint_as_float(rr[1]); }
    l_reg = l_reg * alpha + ps;
#define PK4(P, BASE, OUT) do { unsigned a0 = cvt_pk_bf16(P[BASE + 0], P[BASE + 1]), a1 = cvt_pk_bf16(P[BASE + 2], P[BASE + 3]);   \
    unsigned b0 = cvt_pk_bf16(P[BASE + 4], P[BASE + 5]), b1 = cvt_pk_bf16(P[BASE + 6], P[BASE + 7]);                              \
    auto r0 = __builtin_amdgcn_permlane32_swap(a0, b0, false, false); auto r1 = __builtin_amdgcn_permlane32_swap(a1, b1, false, false); \
    u32x4 w = {r0[0], r1[0], r0[1], r1[1]}; OUT = *reinterpret_cast<bf16x8*>(&w); } while (0)
    PK4(p0, 0, pa0); PK4(p0, 8, pa1); PK4(p1, 0, pa2); PK4(p1, 8, pa3);
#undef PK4
}
__device__ __forceinline__ int v_st(int k, int c) { const int kk = (k & ~0xC) | ((k & 4) << 1) | ((k & 8) >> 1); return ((kk >> 3) * 2 + (c >> 5)) * 512 + ((kk & 7) * 32 + (c & 31)) * 2; }
__device__ __forceinline__ int v_st_nat(int k, int c) { return ((k >> 3) * 2 + (c >> 5)) * 512 + ((k & 7) * 32 + (c & 31)) * 2; }
__device__ __forceinline__ int v_rd_base(int lane) { return ((lane & 3) << 3) | (((lane >> 2) & 3) << 6) | (((lane >> 4) & 1) << 5) | (((lane >> 5) & 1) << 8); }
constexpr int v_rd_off(int d0, int ks, int half) { return d0 * 512 + ks * 2048 + half * 1024; }
template <int OFF> __device__ __forceinline__ s16x4 tr_read(int vb) {
    s16x4 r; asm volatile("ds_read_b64_tr_b16 %0, %1 offset:%2" : "=&v"(r) : "v"(vb), "i"(OFF) : "memory"); return r;
}
template <int D0> __device__ __forceinline__ void pv_one(f32x16& od, int vb, bf16x8 pa0, bf16x8 pa1, bf16x8 pa2, bf16x8 pa3) {
    const s16x4 l0 = tr_read<v_rd_off(D0, 0, 0)>(vb), h0 = tr_read<v_rd_off(D0, 0, 1)>(vb), l1 = tr_read<v_rd_off(D0, 1, 0)>(vb), h1 = tr_read<v_rd_off(D0, 1, 1)>(vb);
    const s16x4 l2 = tr_read<v_rd_off(D0, 2, 0)>(vb), h2 = tr_read<v_rd_off(D0, 2, 1)>(vb), l3 = tr_read<v_rd_off(D0, 3, 0)>(vb), h3 = tr_read<v_rd_off(D0, 3, 1)>(vb);
    asm volatile("s_waitcnt lgkmcnt(0)" ::: "memory"); SBAR();
#define PK(L, H) (bf16x8){L[0], L[1], L[2], L[3], H[0], H[1], H[2], H[3]}
    od = __builtin_amdgcn_mfma_f32_32x32x16_bf16(pa0, PK(l0, h0), od, 0, 0, 0);
    od = __builtin_amdgcn_mfma_f32_32x32x16_bf16(pa1, PK(l1, h1), od, 0, 0, 0);
    od = __builtin_amdgcn_mfma_f32_32x32x16_bf16(pa2, PK(l2, h2), od, 0, 0, 0);
    od = __builtin_amdgcn_mfma_f32_32x32x16_bf16(pa3, PK(l3, h3), od, 0, 0, 0);
#undef PK
}
__device__ __forceinline__ void pv2(f32x16* o, int vb, bf16x8 pa0, bf16x8 pa1, bf16x8 pa2, bf16x8 pa3) {
    pv_one<0>(o[0], vb, pa0, pa1, pa2, pa3); pv_one<1>(o[1], vb, pa0, pa1, pa2, pa3);
}

namespace mla {
constexpr int KROW = 272, SHM_V = 8192, SHM_K = 64 * KROW, NSLOT = 3, OFF_V = 0, OFF_K = NSLOT * SHM_V, OFF_WS = OFF_K + NSLOT * SHM_K;
constexpr int QROW = 208, OFF_Q = OFF_WS + 2048, Q_WAVE = 32 * QROW;
struct VFrag { s16x4 l[2][4], h[2][4]; };
__device__ __forceinline__ void vread(VFrag& f, int vb) {
#define VR(D0, KS) f.l[D0][KS] = tr_read<v_rd_off(D0, KS, 0)>(vb); f.h[D0][KS] = tr_read<v_rd_off(D0, KS, 1)>(vb)
    VR(0, 0); VR(0, 1); VR(0, 2); VR(0, 3); VR(1, 0); VR(1, 1); VR(1, 2); VR(1, 3);
#undef VR
}
template <int B_> __device__ __forceinline__ void kread(bf16x8* kf, bf16x8* qf, const char* kb, const char* qb) {
#pragma unroll
    for (int i = 0; i < 2; ++i) { kf[2 * i] = *reinterpret_cast<const bf16x8*>(kb + (2 * B_ + i) * 32); kf[2 * i + 1] = *reinterpret_cast<const bf16x8*>(kb + 32 * KROW + (2 * B_ + i) * 32);
        qf[i] = *reinterpret_cast<const bf16x8*>(qb + (2 * B_ + i) * 32); }
}
template <int D0> __device__ __forceinline__ void pv_mma(f32x16& od, const VFrag& f, bf16x8 pa0, bf16x8 pa1, bf16x8 pa2, bf16x8 pa3) {
#define PK(L, H) (bf16x8){L[0], L[1], L[2], L[3], H[0], H[1], H[2], H[3]}
    od = __builtin_amdgcn_mfma_f32_32x32x16_bf16(pa0, PK(f.l[D0][0], f.h[D0][0]), od, 0, 0, 0);
    od = __builtin_amdgcn_mfma_f32_32x32x16_bf16(pa1, PK(f.l[D0][1], f.h[D0][1]), od, 0, 0, 0);
    od = __builtin_amdgcn_mfma_f32_32x32x16_bf16(pa2, PK(f.l[D0][2], f.h[D0][2]), od, 0, 0, 0);
    od = __builtin_amdgcn_mfma_f32_32x32x16_bf16(pa3, PK(f.l[D0][3], f.h[D0][3]), od, 0, 0, 0);
#undef PK
}
#define MLA_BAR() asm volatile("s_waitcnt lgkmcnt(0)\n\ts_barrier" ::: "memory")
#define LWAIT() do { asm volatile("s_waitcnt lgkmcnt(0)" ::: "memory"); SBAR(); } while (0)
__device__ __forceinline__ void unit(const bf16_t* __restrict__ Qg, const bf16_t* __restrict__ KVg, const bf16_t* __restrict__ KRg, bf16_t* __restrict__ Og, const f32x2* __restrict__ rope,
                                     int tok0, int seq, int h, int qb, char* lds, const int tid) {
    const int wid = __builtin_amdgcn_readfirstlane(tid >> 6), lane = tid & 63, r32 = lane & 31, hi = lane >> 5;
    const int grp = wid >> 2;
    char* V_lds = lds + OFF_V; char* K_lds = lds + OFF_K;
    float* al_l = (float*)(lds + OFF_WS) + wid * 64;
    f32x16 o[3]; o[0] = f32x16{}; o[1] = f32x16{}; o[2] = f32x16{}; bf16x8 qr[6];
    f32x16 negm = f32x16{};
    const bf16_t* Qw = Qg + (size_t)(tok0 + qb * 256 + wid * 32 + r32) * NQ + h * 96 + hi * 8;
#pragma unroll
    for (int d0 = 0; d0 < 6; ++d0) qr[d0] = *reinterpret_cast<const bf16x8*>(Qw + d0 * 16);
    {
        const f32x4* rp = (const f32x4*)(rope + (size_t)(qb * 256 + wid * 32 + r32) * 16 + 8 * hi);
        u32x4 a = *reinterpret_cast<u32x4*>(&qr[4]), b = *reinterpret_cast<u32x4*>(&qr[5]);
#pragma unroll
        for (int p = 0; p < 4; ++p) { const f32x4 cs = rp[p];
            const float x1a = bf_lo(a[p]), x1b = bf_hi(a[p]), x2a = bf_lo(b[p]), x2b = bf_hi(b[p]);
            a[p] = cvt_pk_bf16(x1a * cs[0] - x2a * cs[1], x1b * cs[2] - x2b * cs[3]);
            b[p] = cvt_pk_bf16(x2a * cs[0] + x1a * cs[1], x2b * cs[2] + x1b * cs[3]); }
        qr[4] = *reinterpret_cast<bf16x8*>(&a); qr[5] = *reinterpret_cast<bf16x8*>(&b);
    }
    char* qbw = lds + OFF_Q + wid * Q_WAVE + r32 * QROW + hi * 16;
#pragma unroll
    for (int d0 = 0; d0 < 6; ++d0) *reinterpret_cast<bf16x8*>(qbw + d0 * 32) = qr[d0];
    const char* qb_ = qbw;
    const int srow = tid >> 3, sc = (tid & 7) * 8;
    const bf16_t* kvp = KVg + (size_t)(tok0 + srow) * NKV + h * 128 + sc;
    const int rrow = (tid >> 2) & 63, rc = (tid & 3) * 8;
    const bf16_t* krp = KRg + (size_t)(tok0 + rrow) * 32 + rc;
    const int vst = v_st_nat(srow, sc), kst = srow * KROW + sc * 2, rst = rrow * KROW + (64 + rc) * 2;
    const bool do_r = wid < 4;
    const int vb0 = (int)(uintptr_t)V_lds + v_rd_base(lane);
    const char* kb0 = K_lds + r32 * KROW + hi * 16;
    const u32x4 ones_u = {0x3f803f80u, 0x3f803f80u, 0x3f803f80u, 0x3f803f80u}; const bf16x8 ones = *reinterpret_cast<const bf16x8*>(&ones_u);
    bf16x8 sv, sk, sr; sr = bf16x8{};
#define SLOAD(k0) do { sv = *reinterpret_cast<const bf16x8*>(kvp + (size_t)(k0) * NKV + 64); sk = *reinterpret_cast<const bf16x8*>(kvp + (size_t)(k0) * NKV); if (do_r) sr = *reinterpret_cast<const bf16x8*>(krp + (size_t)(k0) * 32); } while (0)
#define SWRITE(s) do { *(bf16x8*)(V_lds + (s) * SHM_V + vst) = sv; *(bf16x8*)(K_lds + (s) * SHM_K + kst) = sk; if (do_r) *(bf16x8*)(K_lds + (s) * SHM_K + rst) = sr; } while (0)
#define SOFTMAX_Y(FIRST) do { \
    float rm; {   \
      float ca = fmaxf(fmaxf(p0[0], p0[1]), p0[2]), cb = fmaxf(fmaxf(p0[8], p0[9]), p0[10]), cc = fmaxf(fmaxf(p1[0], p1[1]), p1[2]), cd = fmaxf(fmaxf(p1[8], p1[9]), p1[10]); \
      ca = fmaxf(fmaxf(ca, p0[3]), p0[4]); cb = fmaxf(fmaxf(cb, p0[11]), p0[12]); cc = fmaxf(fmaxf(cc, p1[3]), p1[4]); cd = fmaxf(fmaxf(cd, p1[11]), p1[12]); \
      ca = fmaxf(fmaxf(ca, p0[5]), p0[6]); cb = fmaxf(fmaxf(cb, p0[13]), p0[14]); cc = fmaxf(fmaxf(cc, p1[5]), p1[6]); cd = fmaxf(fmaxf(cd, p1[13]), p1[14]); \
      ca = fmaxf(ca, p0[7]); cb = fmaxf(cb, p0[15]); cc = fmaxf(cc, p1[7]); cd = fmaxf(cd, p1[15]); \
      rm = fmaxf(fmaxf(fmaxf(ca, cb), cc), cd); } \
    { auto rr_ = __builtin_amdgcn_permlane32_swap(__float_as_uint(rm), __float_as_uint(rm), false, false); rm = fmaxf(__uint_as_float(rr_[0]), __uint_as_float(rr_[1])); } \
    if ((FIRST) || __any(rm > SM_THR)) { \
        const float dl = (FIRST) ? rm : fmaxf(rm, 0.f); \
        _Pragma("unroll") for (int r = 0; r < 16; ++r) { p0[r] -= dl; p1[r] -= dl; negm[r] -= dl; } \
        if (!(FIRST)) { const float al_ = __builtin_amdgcn_exp2f(-dl); if (hi == 0) al_l[r32] = al_; asm volatile("s_waitcnt lgkmcnt(0)" ::: "memory"); \
            _Pragma("unroll") for (int d = 0; d < 3; ++d) _Pragma("unroll") for (int r = 0; r < 16; ++r) o[d][r] *= al_l[crow(r, hi)]; } \
    } \
    _Pragma("unroll") for (int r = 0; r < 16; ++r) { p0[r] = __builtin_amdgcn_exp2f(p0[r]); p1[r] = __builtin_amdgcn_exp2f(p1[r]); } \
    PK4_(p0, 0, pa0); PK4_(p0, 8, pa1); PK4_(p1, 0, pa2); PK4_(p1, 8, pa3); } while (0)
#define PK4_(P, BASE, OUT) do { u32x4 w = {cvt_pk_bf16(P[BASE + 0], P[BASE + 1]), cvt_pk_bf16(P[BASE + 2], P[BASE + 3]), cvt_pk_bf16(P[BASE + 4], P[BASE + 5]), cvt_pk_bf16(P[BASE + 6], P[BASE + 7])}; \
    OUT = *reinterpret_cast<bf16x8*>(&w); } while (0)
#define QKA() do { p0 = __builtin_amdgcn_mfma_f32_32x32x16_bf16(kf[0], qf[0], negm, 0, 0, 0); p1 = __builtin_amdgcn_mfma_f32_32x32x16_bf16(kf[1], qf[0], negm, 0, 0, 0); \
    p0 = __builtin_amdgcn_mfma_f32_32x32x16_bf16(kf[2], qf[1], p0, 0, 0, 0); p1 = __builtin_amdgcn_mfma_f32_32x32x16_bf16(kf[3], qf[1], p1, 0, 0, 0); } while (0)
#define QKB() do { p0 = __builtin_amdgcn_mfma_f32_32x32x16_bf16(kf[0], qf[0], p0, 0, 0, 0); p1 = __builtin_amdgcn_mfma_f32_32x32x16_bf16(kf[1], qf[0], p1, 0, 0, 0); \
    p0 = __builtin_amdgcn_mfma_f32_32x32x16_bf16(kf[2], qf[1], p0, 0, 0, 0); p1 = __builtin_amdgcn_mfma_f32_32x32x16_bf16(kf[3], qf[1], p1, 0, 0, 0); } while (0)
#define ONES4() do { o[2] = __builtin_amdgcn_mfma_f32_32x32x16_bf16(pa0, ones, o[2], 0, 0, 0); o[2] = __builtin_amdgcn_mfma_f32_32x32x16_bf16(pa1, ones, o[2], 0, 0, 0); \
    o[2] = __builtin_amdgcn_mfma_f32_32x32x16_bf16(pa2, ones, o[2], 0, 0, 0); o[2] = __builtin_amdgcn_mfma_f32_32x32x16_bf16(pa3, ones, o[2], 0, 0, 0); } while (0)
    f32x16 p0, p1; bf16x8 pa0, pa1, pa2, pa3; const int NT = seq / 64;
    SLOAD(0); SWRITE(0); SLOAD(64); SWRITE(1); if (2 < NT) SLOAD(128);
    __syncthreads();
    if (grp) MLA_BAR();
    bf16x8 kf[4], qf[2]; VFrag vf;
    kread<0>(kf, qf, kb0, qb_); LWAIT(); QKA(); SBAR();
    kread<1>(kf, qf, kb0, qb_); LWAIT(); QKB(); SBAR();
    kread<2>(kf, qf, kb0, qb_); LWAIT(); QKB(); SBAR();
    MLA_BAR();
    vread(vf, vb0); SBAR();
    SOFTMAX_Y(true);
    MLA_BAR();
    int sv_ = 0, sk_ = 1, sw_ = 2;
#pragma unroll 1
    for (int t = 0; t + 1 < NT; ++t) {
        SBAR();
        if (grp) { if (t + 2 < NT) SWRITE(sw_); if (t + 3 < NT) SLOAD((t + 3) * 64); }
        const char* kb = kb0 + sk_ * SHM_K;
        __builtin_amdgcn_s_setprio(1);
        kread<0>(kf, qf, kb, qb_); SBAR();
        pv_mma<0>(o[0], vf, pa0, pa1, pa2, pa3); SBAR();
        LWAIT(); QKA(); SBAR();
        kread<1>(kf, qf, kb, qb_); SBAR();
        ONES4(); SBAR();
        LWAIT(); QKB(); SBAR();
        kread<2>(kf, qf, kb, qb_); SBAR();
        pv_mma<1>(o[1], vf, pa0, pa1, pa2, pa3); SBAR();
        LWAIT(); QKB(); SBAR();
        __builtin_amdgcn_s_setprio(0);
        MLA_BAR();
        vread(vf, vb0 + sk_ * SHM_V); SBAR();
        if (!grp) { if (t + 2 < NT) SWRITE(sw_); if (t + 3 < NT) SLOAD((t + 3) * 64); }
        SBAR();
        SOFTMAX_Y(false);
        SBAR();
        MLA_BAR();
        { const int tmp = sv_; sv_ = sk_; sk_ = sw_; sw_ = tmp; }
    }
    SBAR();
    pv_mma<0>(o[0], vf, pa0, pa1, pa2, pa3); pv_mma<1>(o[1], vf, pa0, pa1, pa2, pa3); ONES4();
    MLA_BAR();
    if (!grp) MLA_BAR();
    bf16_t* stg = (bf16_t*)K_lds + wid * 2048;
#pragma unroll
    for (int r = 0; r < 16; ++r) { const int orow = crow(r, hi); const float rl = __builtin_amdgcn_rcpf(o[2][r]);
#pragma unroll
        for (int d0 = 0; d0 < 2; ++d0) stg[orow * 64 + d0 * 32 + r32] = f2bf(o[d0][r] * rl); }
    asm volatile("s_waitcnt lgkmcnt(0)" ::: "memory");
    bf16_t* Ow = Og + (size_t)(tok0 + qb * 256 + wid * 32) * DM + h * 64;
#pragma unroll
    for (int i = 0; i < 4; ++i) { const int row = i * 8 + (lane >> 3), ch = lane & 7; const u32x4 v = *(const u32x4*)(stg + row * 64 + ch * 8); *(u32x4*)(Ow + (size_t)row * DM + ch * 8) = v; }
    __syncthreads();
#undef SLOAD
#undef SWRITE
#undef SOFTMAX_Y
#undef PK4_
#undef QKA
#undef QKB
#undef ONES4
}
__device__ __forceinline__ void phase(const bf16_t* Q, const bf16_t* KV, const bf16_t* KR, bf16_t* O, const f32x2* rope, char* lds, const int tid, const int b, const int G) {
    if (G == 256) {
        const int xcd = b & 7, c = b >> 3;
        for (int i = 0; i < 16; ++i) unit(Q, KV, KR, O, rope, xcd * 8192, 8192, i, c, lds, tid);
        for (int j = 0; j < 8; ++j) unit(Q, KV, KR, O, rope, TP + xcd * 4096, 4096, 2 * j + (c >> 4), c & 15, lds, tid);
    } else {
        for (int u = b; u < 4096 + 2048; u += G) {
            if (u < 4096) unit(Q, KV, KR, O, rope, (u >> 9) * 8192, 8192, (u >> 5) & 15, u & 31, lds, tid);
            else { const int v = u - 4096; unit(Q, KV, KR, O, rope, TP + (v >> 8) * 4096, 4096, (v >> 4) & 15, v & 15, lds, tid); }
        }
    }
}
}

namespace na {
constexpr int KRB = 144, SLOT_K = 128 * KRB, SLOT_V = 16384, SLOT = SLOT_K + SLOT_V, NSL = 3, OFF_BIAS = NSL * SLOT, OFF_WS = OFF_BIAS + 29760;
template <int OFF> __device__ __forceinline__ s16x4 trr(int vb) { s16x4 r; asm volatile("ds_read_b64_tr_b16 %0, %1 offset:%2" : "=&v"(r) : "v"(vb), "i"(OFF) : "memory"); return r; }
constexpr int vro(int d0, int ks, int half) { return d0 * 512 + half * 1024 + (ks & 1) * 2048 + (ks >> 1) * 8192; }
template <int D0> __device__ __forceinline__ void pv_blk(f32x16& od, int vb, bf16x8 pa0, bf16x8 pa1, bf16x8 pa2, bf16x8 pa3) {
    const s16x4 l0 = trr<vro(D0, 0, 0)>(vb), h0 = trr<vro(D0, 0, 1)>(vb), l1 = trr<vro(D0, 1, 0)>(vb), h1 = trr<vro(D0, 1, 1)>(vb);
    const s16x4 l2 = trr<vro(D0, 2, 0)>(vb), h2 = trr<vro(D0, 2, 1)>(vb), l3 = trr<vro(D0, 3, 0)>(vb), h3 = trr<vro(D0, 3, 1)>(vb);
    asm volatile("s_waitcnt lgkmcnt(0)" ::: "memory"); SBAR();
#define PK(L, H) (bf16x8){L[0], L[1], L[2], L[3], H[0], H[1], H[2], H[3]}
    od = __builtin_amdgcn_mfma_f32_32x32x16_bf16(pa0, PK(l0, h0), od, 0, 0, 0);
    od = __builtin_amdgcn_mfma_f32_32x32x16_bf16(pa1, PK(l1, h1), od, 0, 0, 0);
    od = __builtin_amdgcn_mfma_f32_32x32x16_bf16(pa2, PK(l2, h2), od, 0, 0, 0);
    od = __builtin_amdgcn_mfma_f32_32x32x16_bf16(pa3, PK(l3, h3), od, 0, 0, 0);
#undef PK
}
__device__ __forceinline__ void phase(const bf16_t* __restrict__ QKV, bf16_t* __restrict__ Og, const float* __restrict__ rpb, char* lds, const int tid, const int bid, const int G) {
    const int wid = __builtin_amdgcn_readfirstlane(tid >> 6), lane = tid & 63, r32 = lane & 31, hi = lane >> 5;
    float* bias = (float*)(lds + OFF_BIAS);
    for (int i = tid; i < 16 * 15 * 31; i += 512) bias[i] = rpb[i] * LOG2E;
    float* al_l = (float*)(lds + OFF_WS) + wid * 32;
    const int g = wid & 3, kc0 = min(max(16 * g - 8, 0), 32);
    const int qcol = 16 * g + (r32 & 15), cs = min(max(qcol - 8, 0), 48);
    const int tw = kc0 + 4 * hi - cs;
    const int kbw = (kc0 + r32) * KRB + hi * 16;
    const int vbw = (int)(uintptr_t)lds + SLOT_K + (kc0 >> 3) * 1024 + v_rd_base(lane);
    const int srho0 = tid >> 3, sdc = (tid & 7) * 8;
    const int kst0 = srho0 * KRB + sdc * 2, kst1 = (srho0 + 64) * KRB + sdc * 2;
    const int scol = srho0 & 63;
    const int vst0 = SLOT_K + (((srho0 >> 6) * 8 + (scol >> 3)) * 2 + (sdc >> 5)) * 512 + ((scol & 7) * 32 + (sdc & 31)) * 2, vst1 = vst0 + 8192;
    const int nunits = 6144, per = (nunits + G - 1) / G;
#pragma unroll 1
    for (int ii = 0; ii < per; ++ii) {
        int h, rg, rows, tokb;
        if (G == 256) {
            const int xcd = bid & 7, c = bid >> 3;
            if (ii < 16) { h = ii; rg = c; rows = 128; tokb = xcd * 8192; } else { h = 2 * (ii - 16) + (c >> 4); rg = c & 15; rows = 64; tokb = TP + xcd * 4096; }
        } else {
            const int u = bid * per + ii; if (u >= nunits) break;
            h = u & 15; int gg = u >> 4;
            if (gg < 256) { rg = gg & 31; rows = 128; tokb = (gg >> 5) * 8192; } else { gg -= 256; rg = gg & 15; rows = 64; tokb = TP + (gg >> 4) * 4096; }
        }
        const int r0 = rg * 4, rsb = min(max(r0 - 4, 0), rows - 8);
        const int r = r0 + 2 * (wid >> 2);
        const int rs0 = min(max(r - 4, 0), rows - 8), rs1 = min(max(r - 3, 0), rows - 8);
        const int toff = (rs0 - rsb) >> 1;
        const int ntile = 5 + ((min(max(r0 - 2, 0), rows - 8) - rsb) >> 1);
        const int qrow = r + ((r32 >> 4) & 1), rsq = (r32 & 16) ? rs1 : rs0;
        const bf16_t* qp = QKV + (size_t)(tokb + qrow * 64 + qcol) * 3072 + h * 64 + hi * 8;
        bf16x8 qr[4];
#pragma unroll
        for (int d0 = 0; d0 < 4; ++d0) qr[d0] = *reinterpret_cast<const bf16x8*>(qp + d0 * 16);
        const bf16_t* gbase = QKV + (size_t)tokb * 3072 + 1024 + h * 64 + (size_t)scol * 3072 + sdc;
        bf16x8 sk0, sk1, sv0, sv1;
#define NA_GLOAD(tau) do { const int ra_ = min(rsb + 2 * (tau), rows - 1), rb_ = min(rsb + 2 * (tau) + 1, rows - 1); \
            const bf16_t* pa_ = gbase + (size_t)ra_ * (64 * 3072); const bf16_t* pb_ = gbase + (size_t)rb_ * (64 * 3072); \
            sk0 = *reinterpret_cast<const bf16x8*>(pa_); sv0 = *reinterpret_cast<const bf16x8*>(pa_ + 1024); sk1 = *reinterpret_cast<const bf16x8*>(pb_); sv1 = *reinterpret_cast<const bf16x8*>(pb_ + 1024); } while (0)
#define NA_LWRITE(slot) do { char* sb_ = lds + (slot) * SLOT; *(bf16x8*)(sb_ + kst0) = sk0; *(bf16x8*)(sb_ + kst1) = sk1; *(bf16x8*)(sb_ + vst0) = sv0; *(bf16x8*)(sb_ + vst1) = sv1; } while (0)
        __syncthreads();
        NA_GLOAD(0); NA_LWRITE(0); NA_GLOAD(1); NA_LWRITE(1); NA_GLOAD(2);
        float m_reg = -1e30f, l_reg = 0.f; f32x16 o[2]; o[0] = f32x16{}; o[1] = f32x16{};
        const float* bh = bias + h * (15 * 31);
        int s0 = 0, s1 = 1, s2 = 2;
#pragma unroll 1
        for (int s = 0; s < 5; ++s) {
            __syncthreads();
            if (s + 2 < ntile) NA_LWRITE(s2);
            if (s + 3 < ntile) NA_GLOAD(s + 3);
            SBAR();
            const int slot = toff ? s1 : s0;
            const char* kb = lds + slot * SLOT + kbw;
            bf16x8 ka[8];
#pragma unroll
            for (int d0 = 0; d0 < 4; ++d0) { ka[d0] = *reinterpret_cast<const bf16x8*>(kb + d0 * 32); ka[4 + d0] = *reinterpret_cast<const bf16x8*>(kb + 64 * KRB + d0 * 32); }
            f32x16 p0 = f32x16{}, p1 = f32x16{};
#pragma unroll
            for (int d0 = 0; d0 < 4; ++d0) { p0 = __builtin_amdgcn_mfma_f32_32x32x16_bf16(ka[d0], qr[d0], p0, 0, 0, 0); p1 = __builtin_amdgcn_mfma_f32_32x32x16_bf16(ka[4 + d0], qr[d0], p1, 0, 0, 0); }
            const int kra = rs0 + 2 * s;
            const bool oka = (unsigned)(kra - rsq) < 8u, okb = (unsigned)(kra + 1 - rsq) < 8u;
            const float* bl = bh + (kra - qrow + 7) * 31 + (kc0 + 4 * hi - qcol + 15);
#pragma unroll
            for (int rr = 0; rr < 16; ++rr) { const int k0 = (rr & 3) + 8 * (rr >> 2); const bool okc = (unsigned)(tw + k0) < 16u;
                p0[rr] = (okc && oka) ? p0[rr] + bl[k0] : -1e30f;
                p1[rr] = (okc && okb) ? p1[rr] + bl[k0 + 31] : -1e30f; }
            float mn, alpha; partialSM(p0, p1, m_reg, mn, alpha);
#pragma unroll
            for (int rr = 0; rr < 16; ++rr) p1[rr] = __builtin_amdgcn_exp2f(p1[rr]);
            { float ps = 0.f;
#pragma unroll
              for (int rr = 0; rr < 16; ++rr) ps += p0[rr] + p1[rr];
              auto sw = __builtin_amdgcn_permlane32_swap(__float_as_uint(ps), __float_as_uint(ps), false, false); l_reg = l_reg * alpha + (__uint_as_float(sw[0]) + __uint_as_float(sw[1])); }
            bf16x8 pa0, pa1, pa2, pa3;
#define PKD(P, B, OUT) do { u32x4 w_ = {cvt_pk_bf16(P[B + 0], P[B + 1]), cvt_pk_bf16(P[B + 2], P[B + 3]), cvt_pk_bf16(P[B + 4], P[B + 5]), cvt_pk_bf16(P[B + 6], P[B + 7])}; OUT = *reinterpret_cast<bf16x8*>(&w_); } while (0)
            PKD(p0, 0, pa0); PKD(p0, 8, pa1); PKD(p1, 0, pa2); PKD(p1, 8, pa3);
#undef PKD
            if (__any(alpha < 1.f)) { if (hi == 0) al_l[r32] = alpha; asm volatile("s_waitcnt lgkmcnt(0)" ::: "memory");
#pragma unroll
                for (int d = 0; d < 2; ++d)
#pragma unroll
                    for (int rr = 0; rr < 16; ++rr) o[d][rr] *= al_l[crow(rr, hi)]; }
            SBAR();
            const int vb = vbw + slot * SLOT;
            pv_blk<0>(o[0], vb, pa0, pa1, pa2, pa3); pv_blk<1>(o[1], vb, pa0, pa1, pa2, pa3);
            { const int t_ = s0; s0 = s1; s1 = s2; s2 = t_; }
        }
#undef NA_GLOAD
#undef NA_LWRITE
        if (hi == 0) al_l[r32] = l_reg; asm volatile("s_waitcnt lgkmcnt(0)" ::: "memory");
        bf16_t* Ow = Og + (size_t)(tokb + r * 64 + 16 * g) * DM + h * 64;
#pragma unroll
        for (int rr = 0; rr < 16; ++rr) { const int q = crow(rr, hi); const float rl = __builtin_amdgcn_rcpf(al_l[q]); bf16_t* op = Ow + (size_t)((q >> 4) * 64 + (q & 15)) * DM + r32;
            op[0] = f2bf(o[0][rr] * rl); op[32] = f2bf(o[1][rr] * rl); }
        asm volatile("s_waitcnt lgkmcnt(0)" ::: "memory");
    }
}
}

#define XB_TMO      128
#define XB_XCNT(j)  (256  + 64 * (j))
#define XB_XSUB(j)  (1280 + 64 * (j))
#define XB_XGEN(j)  (2304 + 64 * (j))
#define XB_TOP      3328
#define XB_TOPGEN   3392
#define XCD_BAR_WORDS 3456
#define XB_SPIN_CAP (1u << 18)

__device__ __forceinline__ unsigned xb_ld(unsigned* p)              { return __hip_atomic_load(p, __ATOMIC_RELAXED, __HIP_MEMORY_SCOPE_AGENT); }
__device__ __forceinline__ unsigned xb_add(unsigned* p, unsigned v) { return __hip_atomic_fetch_add(p, v, __ATOMIC_RELAXED, __HIP_MEMORY_SCOPE_AGENT); }
__device__ __forceinline__ unsigned xb_xcc_id() { return (unsigned)__builtin_amdgcn_s_getreg((3 << 11) | 20) & 0xFu; }
#define XB_SPIN(cond, bar) do { unsigned _sp = 0; while (cond) { __builtin_amdgcn_s_sleep(1); \
    if ((++_sp & 255u) == 0u) { if (xb_ld(&(bar)[XB_TMO])) break; if (_sp > XB_SPIN_CAP) { atomicAdd(&(bar)[XB_TMO], 1u); break; } } } } while (0)

struct XcdBarrier {
    unsigned* bar; unsigned x;
    volatile LAS unsigned* st;
};

__device__ __forceinline__ XcdBarrier xcd_barrier_post(unsigned* bar, volatile LAS unsigned* st) {
    XcdBarrier b; b.bar = bar; b.x = xb_xcc_id(); b.st = st;
    if (threadIdx.x == 0) (void)xb_add(&bar[XB_XCNT(b.x)], 1u);
    return b;
}
__device__ __forceinline__ void xcd_barrier_complete(unsigned* bar, unsigned x, unsigned& nloc, unsigned& nx) {
    const unsigned G = gridDim.x * gridDim.y * gridDim.z;
    unsigned sum, cnt, mine, sp = 0u;
    for (;;) {
        sum = 0u; cnt = 0u; mine = 0u;
#pragma unroll
        for (unsigned j = 0; j < 16; ++j) { const unsigned c = xb_ld(&bar[XB_XCNT(j)]); sum += c; cnt += (c > 0u) ? 1u : 0u; mine = (j == x) ? c : mine; }
        if (sum == G) break;
        __builtin_amdgcn_s_sleep(1);
        if ((++sp & 255u) == 0u) { if (xb_ld(&bar[XB_TMO])) break; if (sp > XB_SPIN_CAP) { atomicAdd(&bar[XB_TMO], 1u); break; } }
    }
    nloc = mine > 0u ? mine : 1u; nx = cnt > 0u ? cnt : 1u;
}

__device__ __forceinline__ void xcd_barrier(const XcdBarrier& b) {
    asm volatile("s_waitcnt vmcnt(0)" ::: "memory");
    __syncthreads();
    if (threadIdx.x == 0) {
        unsigned* bar = b.bar;
        __builtin_amdgcn_s_waitcnt(0);
        unsigned nloc = b.st[0], nx = b.st[1];
        if (nloc == 0u) { xcd_barrier_complete(bar, b.x, nloc, nx); b.st[0] = nloc; b.st[1] = nx; }
        const unsigned old = xb_add(&bar[XB_XSUB(b.x)], 1u);
        const unsigned gen = old / nloc;
        if (old + 1u == (gen + 1u) * nloc) {
            __builtin_amdgcn_fence(__ATOMIC_RELEASE, "agent");
            asm volatile("s_waitcnt vmcnt(0)" ::: "memory");
            const unsigned og = xb_add(&bar[XB_TOP], 1u);
            const unsigned tg = og / nx;
            if (og + 1u == (tg + 1u) * nx) xb_add(&bar[XB_TOPGEN], 1u);
            else XB_SPIN(xb_ld(&bar[XB_TOPGEN]) == tg, bar);
            __builtin_amdgcn_fence(__ATOMIC_ACQUIRE, "agent");
            xb_add(&bar[XB_XGEN(b.x)], 1u);
            asm volatile("s_waitcnt vmcnt(0)" ::: "memory");
        } else {
            XB_SPIN(xb_ld(&bar[XB_XGEN(b.x)]) == gen, bar);
            __builtin_amdgcn_fence(__ATOMIC_ACQUIRE, "agent");
            asm volatile("s_waitcnt vmcnt(0)" ::: "memory");
        }
    }
    __syncthreads();
}


struct RowP { const float* xin0; const float* xin1; const bf16_t* h; const float* gpost; const float* gate; float* xout; bf16_t* hn; const float* g2; const float* scale; const float* shift; };
template <bool HAS_H, bool HAS_HN, bool XIN_BF, bool XOUT_BF>
__device__ __forceinline__ void rowpass(const RowP P, int gw, int ngw, int lane) {
    const int rpw = (T + ngw - 1) / ngw; const int r0 = gw * rpw, r1 = min(T, r0 + rpw);
    int cur_bb = -1; f32x4 A[4], B[4], C[4];
#pragma unroll
    for (int j = 0; j < 4; ++j) { A[j] = f32x4{}; B[j] = f32x4{}; C[j] = f32x4{}; }
    for (int t = r0; t < r1; ++t) {
        const int bb = tok_bb(t);
        if (bb != cur_bb) { cur_bb = bb;
#pragma unroll
            for (int j = 0; j < 4; ++j) { const int col = 4 * lane + 256 * j;
                if (HAS_H) A[j] = *(const f32x4*)(P.gpost + col) * *(const f32x4*)(P.gate + (size_t)bb * 6144 + col);
                if (HAS_HN) { B[j] = *(const f32x4*)(P.g2 + col) * (*(const f32x4*)(P.scale + (size_t)bb * 6144 + col) + 1.f); C[j] = *(const f32x4*)(P.shift + (size_t)bb * 6144 + col); } } }
        f32x4 xv[4];
        if (XIN_BF) { const bf16_t* xb = (const bf16_t*)(P.xout + (size_t)t * DM);
#pragma unroll
            for (int j = 0; j < 4; ++j) { const u32x2 w = *(const u32x2*)(xb + 4 * lane + 256 * j); xv[j] = (f32x4){bf_lo(w.x), bf_hi(w.x), bf_lo(w.y), bf_hi(w.y)}; }
        } else { const float* xr = t < TP ? P.xin0 + (size_t)t * DM : P.xin1 + (size_t)(t - TP) * DM;
#pragma unroll
            for (int j = 0; j < 4; ++j) xv[j] = *(const f32x4*)(xr + 4 * lane + 256 * j); }
        if (HAS_H) {
            const bf16_t* hr = P.h + (size_t)t * DM; f32x4 hv[4]; float ss = 0.f;
#pragma unroll
            for (int j = 0; j < 4; ++j) { const u32x2 w = *(const u32x2*)(hr + 4 * lane + 256 * j); hv[j] = (f32x4){bf_lo(w.x), bf_hi(w.x), bf_lo(w.y), bf_hi(w.y)};
                ss += (hv[j][0] * hv[j][0] + hv[j][1] * hv[j][1]) + (hv[j][2] * hv[j][2] + hv[j][3] * hv[j][3]); }
            const float rstd = __builtin_amdgcn_rsqf(wave_sum(ss) * (1.f / DM) + RMS_EPS);
            float* xo = P.xout + (size_t)t * DM;
#pragma unroll
            for (int j = 0; j < 4; ++j) { xv[j] = xv[j] + A[j] * (hv[j] * rstd);
                if (XOUT_BF) { u32x2 w; w.x = cvt_pk_bf16(xv[j][0], xv[j][1]); w.y = cvt_pk_bf16(xv[j][2], xv[j][3]); *(u32x2*)((bf16_t*)xo + 4 * lane + 256 * j) = w; }
                else *(f32x4*)(xo + 4 * lane + 256 * j) = xv[j]; }
        }
        if (HAS_HN) {
            float ss = 0.f;
#pragma unroll
            for (int j = 0; j < 4; ++j) ss += (xv[j][0] * xv[j][0] + xv[j][1] * xv[j][1]) + (xv[j][2] * xv[j][2] + xv[j][3] * xv[j][3]);
            const float rstd = __builtin_amdgcn_rsqf(wave_sum(ss) * (1.f / DM) + RMS_EPS);
            bf16_t* ho = P.hn + (size_t)t * DM;
#pragma unroll
            for (int j = 0; j < 4; ++j) { const f32x4 v = xv[j] * rstd * B[j] + C[j]; u32x2 w; w.x = cvt_pk_bf16(v[0], v[1]); w.y = cvt_pk_bf16(v[2], v[3]); *(u32x2*)(ho + 4 * lane + 256 * j) = w; }
        }
    }
}
__device__ __forceinline__ void lat_rowpass(const float* lat, const float* qn, const float* kvn, const f32x2* rope, bf16_t* CQ, bf16_t* CKV, bf16_t* KR, int gw, int ngw, int lane) {
    const int rpw = (T + ngw - 1) / ngw; const int r0 = gw * rpw, r1 = min(T, r0 + rpw);
    const f32x4 qg = *(const f32x4*)(qn + 4 * lane); const f32x2 kg = *(const f32x2*)(kvn + 2 * lane);
    for (int t = r0; t < r1; ++t) {
        const float* lr = lat + (size_t)t * NLAT;
        const f32x4 q = *(const f32x4*)(lr + 4 * lane); const f32x2 k = *(const f32x2*)(lr + 256 + 2 * lane);
        float x1 = 0.f, x2 = 0.f; if (lane < 16) { x1 = lr[384 + lane]; x2 = lr[400 + lane]; }
        float sq = (q[0] * q[0] + q[1] * q[1]) + (q[2] * q[2] + q[3] * q[3]), sk = k[0] * k[0] + k[1] * k[1];
#pragma unroll
        for (int o = 1; o < 64; o <<= 1) { sq += __shfl_xor(sq, o); sk += __shfl_xor(sk, o); }
        const float rq = __builtin_amdgcn_rsqf(sq * (1.f / 256.f) + RMS_EPS), rk = __builtin_amdgcn_rsqf(sk * (1.f / 128.f) + RMS_EPS);
        u32x2 wq; wq.x = cvt_pk_bf16(q[0] * rq * qg[0], q[1] * rq * qg[1]); wq.y = cvt_pk_bf16(q[2] * rq * qg[2], q[3] * rq * qg[3]);
        *(u32x2*)(CQ + (size_t)t * 256 + 4 * lane) = wq;
        *(unsigned*)(CKV + (size_t)t * 128 + 2 * lane) = cvt_pk_bf16(k[0] * rk * kg[0], k[1] * rk * kg[1]);
        if (lane < 16) { const f32x2 cs = rope[(size_t)tok_pos(t) * 16 + lane];
            KR[(size_t)t * 32 + lane] = f2bf(x1 * cs.x - x2 * cs.y); KR[(size_t)t * 32 + 16 + lane] = f2bf(x2 * cs.x + x1 * cs.y); }
    }
}

__device__ __forceinline__ void transpose_item(const float* W, int K, int N, bf16_t* WT, int k0, int n0, int drow0, LAS float* scr, int lane) {
#pragma unroll 8
    for (int i = 0; i < 32; ++i) { const int kk = 2 * i + (lane >> 5); scr[kk * 33 + (lane & 31)] = W[(size_t)(k0 + kk) * N + n0 + (lane & 31)]; }
    asm volatile("s_waitcnt lgkmcnt(0)" ::: "memory");
    const int c = lane & 7;
#pragma unroll
    for (int j = 0; j < 4; ++j) { const int n = (lane >> 3) + 8 * j; const LAS float* s = scr + (8 * c) * 33 + n;
        u32x4 o; o.x = cvt_pk_bf16(s[0 * 33], s[1 * 33]); o.y = cvt_pk_bf16(s[2 * 33], s[3 * 33]); o.z = cvt_pk_bf16(s[4 * 33], s[5 * 33]); o.w = cvt_pk_bf16(s[6 * 33], s[7 * 33]);
        *(u32x4*)(WT + (size_t)(drow0 + n) * K + k0 + 8 * c) = o; }
    asm volatile("s_waitcnt lgkmcnt(0)" ::: "memory");
}

struct Args { const float* in[21]; float* out; unsigned char* ws; int ph_lo, ph_hi; };
constexpr int N_PHASES = 19;

__global__ void __launch_bounds__(512, 2) fwd_kernel(Args args) {
    extern __shared__ __attribute__((aligned(16))) unsigned char lds[];
    cg::grid_group grid = cg::this_grid();
    if (threadIdx.x < 4) ((LAS unsigned*)((LAS unsigned char*)lds + LDS_ST_OFF))[threadIdx.x] = 0u;
    __syncthreads();
    const XcdBarrier xbar = xcd_barrier_post((unsigned*)(args.ws + WS_BAR), (volatile LAS unsigned*)((LAS unsigned char*)lds + LDS_ST_OFF));
    const int ph_lo = args.ph_lo, ph_hi = args.ph_hi;
    int rep_done = 0;
    for (int ph = ph_lo; ph < ph_hi; ++ph) {
        const unsigned char __attribute__((address_space(4)))* kp = (const unsigned char __attribute__((address_space(4)))*)__builtin_amdgcn_kernarg_segment_ptr();
        asm volatile("" : "+s"(kp));
        int tid = threadIdx.x, bid = blockIdx.x, G = gridDim.x;
        asm volatile("" : "+v"(tid)); asm volatile("" : "+s"(bid)); asm volatile("" : "+s"(G));
        const int lane = tid & 63, wid = __builtin_amdgcn_readfirstlane(tid >> 6);
        const int gw = bid * 8 + wid, ngw = G * 8;
#define AIN(i) (*(const float* const __attribute__((address_space(4)))*)(kp + 8 * (i)))
        float* out = *(float* const __attribute__((address_space(4)))*)(kp + 8 * 21);
        unsigned char* ws = *(unsigned char* const __attribute__((address_space(4)))*)(kp + 8 * 22);
        bf16_t* Wdkv_t = (bf16_t*)(ws + WS_WDKV); bf16_t* Wuq_t = (bf16_t*)(ws + WS_WUQ); bf16_t* Wukv_t = (bf16_t*)(ws + WS_WUKV); bf16_t* Wo_t = (bf16_t*)(ws + WS_WO);
        bf16_t* NAqkv_t = (bf16_t*)(ws + WS_NAQKV); bf16_t* NAo_t = (bf16_t*)(ws + WS_NAO); bf16_t* Wgu_t = (bf16_t*)(ws + WS_WGU); bf16_t* Wdn_t = (bf16_t*)(ws + WS_WDN);
        float* MOD = (float*)(ws + WS_MOD); f32x2* ROPE = (f32x2*)(ws + WS_ROPE);
        bf16_t* HN = (bf16_t*)(ws + WS_HN); bf16_t* OB = HN;
        float* LAT = (float*)(ws + WS_R1); bf16_t* KV = (bf16_t*)(ws + WS_R1); bf16_t* HMIX = (bf16_t*)(ws + WS_R1); bf16_t* QKV = (bf16_t*)(ws + WS_R1);
        bf16_t* HID = (bf16_t*)(ws + WS_HID); bf16_t* QB = (bf16_t*)(ws + WS_Q); bf16_t* KR = (bf16_t*)(ws + WS_KR); bf16_t* CQ = (bf16_t*)(ws + WS_CQ); bf16_t* CKV = (bf16_t*)(ws + WS_CKV);
        const float* x_p = AIN(0); const float* x_s = AIN(1);


        int kind = ph, l = 0; if (ph >= 14) { kind = ph - 7; l = 1; }
        switch (kind) {
        case 0: if (PH_ON(0)) {
            if (bid < 192) {
                float* cact = (float*)lds;
                float* part = (float*)(lds + 65536);
                for (int i = tid; i < 16384; i += 512) { const int bb = i >> 10, k = i & 1023; const float c = bb < 8 ? AIN(2)[bb * 1024 + k] : AIN(3)[(bb - 8) * 1024 + k];
                    cact[k * 16 + bb] = c / (1.f + expf(-c)); }
                __syncthreads();
                const int item = bid, ml = item / 96, n0 = (item % 96) * 64;
                const float* wp = AIN(4) + ((size_t)ml * 1024 + 128 * wid) * 6144 + n0 + lane;
                float acc[16];
#pragma unroll
                for (int i = 0; i < 16; ++i) acc[i] = 0.f;
#pragma unroll 8
                for (int kk = 0; kk < 128; ++kk) { const float w = wp[(size_t)kk * 6144]; const f32x4* cv = (const f32x4*)(cact + (128 * wid + kk) * 16);
#pragma unroll
                    for (int q = 0; q < 4; ++q) { const f32x4 c4 = cv[q]; acc[4 * q] += c4[0] * w; acc[4 * q + 1] += c4[1] * w; acc[4 * q + 2] += c4[2] * w; acc[4 * q + 3] += c4[3] * w; } }
#pragma unroll
                for (int i = 0; i < 16; ++i) part[(wid * 16 + i) * 64 + lane] = acc[i];
                __syncthreads();
                for (int o = tid; o < 1024; o += 512) { const int bb = o >> 6, ln = o & 63; float s = 0.f;
#pragma unroll
                    for (int w = 0; w < 8; ++w) s += part[(w * 16 + bb) * 64 + ln];
                    MOD[((size_t)ml * 16 + bb) * 6144 + n0 + ln] = s + AIN(5)[ml * 6144 + n0 + ln]; }
                __syncthreads();
            }
            for (int idx = bid * 512 + tid; idx < 8192 * 16; idx += G * 512) { const int s = idx >> 4, f = idx & 15;
                const float invf = exp2f(-(float)f * 0.8304820237218405f); const float ang = (float)s * invf;
                double rev = (double)ang * 0.15915494309189535; rev -= floor(rev); const float fr = (float)rev;
                ROPE[idx] = (f32x2){__builtin_amdgcn_cosf(fr), __builtin_amdgcn_sinf(fr)}; }
            { unsigned z_ = 0u; asm volatile("" : "+v"(z_));
              for (int i = bid * 512 + tid; i < 96 * 1024 / 8; i += G * 512) *(u32x4*)(Wdkv_t + (size_t)416 * 1024 + (size_t)i * 8) = (u32x4){z_, z_, z_, z_}; }
            {
                LAS float* scr = (LAS float*)((LAS unsigned char*)lds + wid * 16384);
                constexpr int I0 = 16 * 13, I1 = 4 * 48, I2 = 2 * 64, I3 = 16 * 32, I4 = 16 * 96, I5 = 16 * 32, I6 = 16 * 176, I7 = 44 * 32;
                constexpr int NIT = I0 + I1 + I2 + I3 + I4 + I5 + 2 * I6 + 2 * I7;
                for (int it = gw; it < NIT; it += ngw) {
                    int r = it;
                    if (r < I0) { transpose_item(AIN(10), 1024, 416, Wdkv_t, 64 * (r / 13), 32 * (r % 13), 32 * (r % 13), scr, lane); continue; } r -= I0;
                    if (r < I1) { transpose_item(AIN(13), 256, 1536, Wuq_t, 64 * (r / 48), 32 * (r % 48), 32 * (r % 48), scr, lane); continue; } r -= I1;
                    if (r < I2) { transpose_item(AIN(14), 128, 2048, Wukv_t, 64 * (r / 64), 32 * (r % 64), 32 * (r % 64), scr, lane); continue; } r -= I2;
                    if (r < I3) { transpose_item(AIN(15), 1024, 1024, Wo_t, 64 * (r / 32), 32 * (r % 32), 32 * (r % 32), scr, lane); continue; } r -= I3;
                    if (r < I4) { transpose_item(AIN(16), 1024, 3072, NAqkv_t, 64 * (r / 96), 32 * (r % 96), 32 * (r % 96), scr, lane); continue; } r -= I4;
                    if (r < I5) { transpose_item(AIN(18), 1024, 1024, NAo_t, 64 * (r / 32), 32 * (r % 32), 32 * (r % 32), scr, lane); continue; } r -= I5;
                    if (r < 2 * I6) { const int ll = r / I6; r -= ll * I6; const int n0 = 32 * (r % 176); const int jj = n0 < FF ? n0 : n0 - FF; const int drow = (jj >> 7) * 256 + (n0 < FF ? 0 : 128) + (jj & 127);
                        transpose_item(AIN(19) + (size_t)ll * 1024 * 5632, 1024, 5632, Wgu_t + (size_t)ll * 5632 * 1024, 64 * (r / 176), n0, drow, scr, lane); continue; } r -= 2 * I6;
                    { const int ll = r / I7; r -= ll * I7; transpose_item(AIN(20) + (size_t)ll * FF * 1024, FF, 1024, Wdn_t + (size_t)ll * 1024 * FF, 64 * (r / 32), 32 * (r % 32), 32 * (r % 32), scr, lane); }
                }
            }
        } break;
        case 1: if (PH_ON(1)) {
            RowP P{x_p, x_s, nullptr, nullptr, nullptr, nullptr, HN, AIN(6), MOD + 1 * 1024, MOD + 0 * 1024};
            rowpass<false, true, false, false>(P, gw, ngw, lane);
        } break;
        case 2: if (PH_ON(2)) {
            pg8::Gemm g{HN, Wdkv_t, T, NLAT, 1024}; pg8::StaticOrder S; S.init(T, NLAT, G, bid);
            pg8::EpiLat E{CQ, CKV, KR, AIN(11), AIN(12), ROPE, (LAS float*)((LAS unsigned char*)lds + 131072)};
            pg8::gemm_phase<pg8::EpiLat>((LAS unsigned char*)lds, g, S, E, tid);
        } break;
        case 3: break;
        case 4: case 5: case 7: case 10: case 12: if (PH_ON(5)) {
            pg8::Gemm g; pg8::EpiBf16S E; E.scale_cols = 0; E.scale0 = 1.f;
            if (kind == 4) { g = pg8::Gemm{CQ, Wuq_t, T, NQ, 256}; E.O = QB; E.ldc = NQ; E.scale_cols = NQ; E.scale0 = QSCALE_MLA; }
            else if (kind == 5) { g = pg8::Gemm{CKV, Wukv_t, T, NKV, 128}; E.O = KV; E.ldc = NKV; }
            else if (kind == 7) { g = pg8::Gemm{OB, l ? NAo_t : Wo_t, T, 1024, 1024}; E.O = HMIX; E.ldc = 1024; }
            else if (kind == 10) { g = pg8::Gemm{HID, Wdn_t + (size_t)l * 1024 * FF, T, 1024, FF}; E.O = HMIX; E.ldc = 1024; }
            else { g = pg8::Gemm{HN, NAqkv_t, T, 3072, 1024}; E.O = QKV; E.ldc = 3072; E.scale_cols = 1024; E.scale0 = QSCALE_NA; }
            pg8::StaticOrder S; S.init(T, g.N, G, bid);
            pg8::gemm_phase<pg8::EpiBf16S>((LAS unsigned char*)lds, g, S, E, tid);
        } break;
        case 6: if (PH_ON(6)) {
            mla::phase(QB, KV, KR, OB, ROPE, (char*)lds, tid, bid, G);
        } break;
        case 8: if (PH_ON(8)) {
            const float* md = MOD + (size_t)l * 16 * 6144;
            RowP P{l ? out : x_p, l ? out + (size_t)TP * DM : x_s, HMIX, AIN(7) + l * 1024, md + 2 * 1024, out, HN, AIN(8) + l * 1024, md + 4 * 1024, md + 3 * 1024};
            if (l == 0) rowpass<true, true, false, true>(P, gw, ngw, lane); else rowpass<true, true, true, true>(P, gw, ngw, lane);
        } break;
        case 9: if (PH_ON(9)) {
            pg8::Gemm g{HN, Wgu_t + (size_t)l * 5632 * 1024, T, 5632, 1024}; pg8::StaticOrder S; S.init(T, 5632, G, bid);
            pg8::EpiSwiGLU E{HID};
            pg8::gemm_phase<pg8::EpiSwiGLU>((LAS unsigned char*)lds, g, S, E, tid);
        } break;
        case 11: if (PH_ON(11)) {
            const float* md = MOD + (size_t)l * 16 * 6144; const float* md1 = MOD + (size_t)16 * 6144;
            RowP P{out, out + (size_t)TP * DM, HMIX, AIN(9) + l * 1024, md + 5 * 1024, out, HN, AIN(6) + 1024, md1 + 1 * 1024, md1 + 0 * 1024};
            if (l == 0) rowpass<true, true, true, true>(P, gw, ngw, lane); else rowpass<true, false, true, false>(P, gw, ngw, lane);
        } break;
        case 13: if (PH_ON(13)) {
            na::phase(QKV, OB, AIN(17), (char*)lds, tid, bid, G);
        } break;
        default: break;
        }
#if MK_MULTI
#define SEAM() do { } while (0)
#else
#define SEAM() do { if (ph_lo < 0) grid.sync(); XcdBarrier xb_ = xbar; asm volatile("" : "+s"(xb_.bar)); xcd_barrier(xb_); } while (0)
#endif
        if (REP_MASK != 0 && ((REP_MASK >> ph) & 1) && !rep_done) { rep_done = 1; --ph; SEAM(); continue; }
        rep_done = 0;
        if (ph + 1 < ph_hi && ph != 4 && ph != 3) { SEAM(); for (int e = 0; e < EXTRA_SYNC; ++e) SEAM(); }
    }
}

extern "C" void kernel_launch(void* const* d_in, const int* in_sizes, int n_in, void* d_out, int out_size, void* d_ws, size_t ws_size, hipStream_t stream) {
    static int grid = 0;
    if (grid == 0) {
        if (n_in != 21 || out_size != T * DM || ws_size < WS_END) { fprintf(stderr, "kernel_launch: unexpected shapes: n_in %d out %d ws %zu\n", n_in, out_size, ws_size); grid = -1; return; }
        int dev = 0, cus = 0, per_cu = 0;
        hipGetDevice(&dev); hipDeviceGetAttribute(&cus, hipDeviceAttributeMultiprocessorCount, dev);
        if (hipFuncSetAttribute((const void*)fwd_kernel, hipFuncAttributeMaxDynamicSharedMemorySize, LDS_BYTES) != hipSuccess) { fprintf(stderr, "kernel_launch: hipFuncSetAttribute failed\n"); grid = -1; return; }
        hipOccupancyMaxActiveBlocksPerMultiprocessor(&per_cu, (const void*)fwd_kernel, 512, LDS_BYTES);
        per_cu = 1;
        grid = cus * per_cu;
        fprintf(stderr, "kernel_launch: cus %d per_cu %d grid %d\n", cus, per_cu, grid);
    }
    if (grid < 0) return;
    Args a{};
    for (int i = 0; i < 21; ++i) a.in[i] = (const float*)d_in[i];
    a.out = (float*)d_out; a.ws = (unsigned char*)d_ws;
#if MK_MULTI
    for (int ph = 0; ph < N_PHASES; ++ph) {
        a.ph_lo = ph; a.ph_hi = ph + 1;
        hipLaunchKernelGGL(fwd_kernel, dim3(grid), dim3(512), LDS_BYTES, stream, a);
    }
#else
    a.ph_lo = 0; a.ph_hi = N_PHASES;
    if (hipMemsetAsync((char*)d_ws + WS_BAR, 0, BAR_BYTES, stream) != hipSuccess) { fprintf(stderr, "kernel_launch: memset failed\n"); return; }
    void* kargs[] = {&a};
    hipError_t e = hipLaunchCooperativeKernel((const void*)fwd_kernel, dim3(grid), dim3(512), kargs, LDS_BYTES, stream);
    if (e != hipSuccess) fprintf(stderr, "kernel_launch: cooperative launch failed: %s (grid %d)\n", hipGetErrorString(e), grid);
#endif
}
```

```cpp
#include <hip/hip_runtime.h>
#include <hip/hip_cooperative_groups.h>
#include <cstdio>
#include <cstdint>
namespace cg = cooperative_groups;

#ifndef PH_MASK
#define PH_MASK 0xFFFFF
#endif
#define PH_ON(k) ((PH_MASK >> (k)) & 1)
#ifndef REP_MASK
#define REP_MASK 0
#endif
#ifndef EXTRA_SYNC
#define EXTRA_SYNC 0
#endif
#ifndef MK_MULTI
#define MK_MULTI 0
#endif

#define LAS __attribute__((address_space(3)))
typedef unsigned short bf16_t;
typedef short bf16x8 __attribute__((ext_vector_type(8)));
typedef short s16x4 __attribute__((ext_vector_type(4)));
typedef float f32x2 __attribute__((ext_vector_type(2)));
typedef float f32x4 __attribute__((ext_vector_type(4)));
typedef float f32x16 __attribute__((ext_vector_type(16)));
typedef unsigned u32x2 __attribute__((ext_vector_type(2)));
typedef unsigned u32x4 __attribute__((ext_vector_type(4)));

constexpr int DM = 1024, TP = 65536, T = 98304, FF = 2816;
constexpr int NQ = 1536, NKV = 2048, NLAT = 512;
constexpr float RMS_EPS = 1e-6f;
constexpr float LOG2E = 1.4426950408889634f;
constexpr float QSCALE_MLA = 0.10206207261596577f * LOG2E;
constexpr float QSCALE_NA = 0.125f * LOG2E;

constexpr size_t MiB = 1u << 20;
constexpr size_t WS_WDKV = 0, WS_WUQ = 1 * MiB, WS_WUKV = 2 * MiB, WS_WO = 3 * MiB, WS_NAQKV = 5 * MiB, WS_NAO = 11 * MiB,
                 WS_WGU = 13 * MiB  , WS_WDN = 35 * MiB  , WS_MOD = 46 * MiB, WS_ROPE = 47 * MiB;
constexpr size_t WS_BAR = 48 * MiB, BAR_BYTES = 16384;
constexpr size_t WS_HN = 64 * MiB;
constexpr size_t WS_R1 = 256 * MiB;
constexpr size_t WS_HID = 448 * MiB;
constexpr size_t WS_Q = 640 * MiB;
constexpr size_t WS_KR = 928 * MiB;
constexpr size_t WS_CQ = 934 * MiB;
constexpr size_t WS_CKV = 982 * MiB;
constexpr size_t WS_END = 1006 * MiB;
constexpr int LDS_ST_OFF = 163840 - 64;
constexpr int LDS_BYTES = 163840;

__device__ __forceinline__ unsigned cvt_pk_bf16(float lo, float hi) { unsigned r; asm("v_cvt_pk_bf16_f32 %0, %1, %2" : "=v"(r) : "v"(lo), "v"(hi)); return r; }
__device__ __forceinline__ bf16_t f2bf(float x) { return (bf16_t)(cvt_pk_bf16(x, x) & 0xffffu); }
__device__ __forceinline__ float bf_lo(unsigned u) { return __uint_as_float(u << 16); }
__device__ __forceinline__ float bf_hi(unsigned u) { return __uint_as_float(u & 0xffff0000u); }
__device__ __forceinline__ float wave_sum(float v) {
#pragma unroll
    for (int o = 1; o < 64; o <<= 1) v += __shfl_xor(v, o);
    return v;
}
__device__ __forceinline__ int tok_pos(int t) { return t < TP ? (t & 8191) : (t & 4095); }
__device__ __forceinline__ int tok_bb(int t) { return t < TP ? (t >> 13) : 8 + ((t - TP) >> 12); }

namespace pg8 {
constexpr int BM = 256, BK = 64, HALF = 128, HTB = HALF * BK * 2, NXCD = 8, WGM = 8;
__host__ __device__ __forceinline__ int lds_byte(int r, int c) { const int st = (r >> 4) * 2 + (c >> 5), rr = r & 15, cc = c & 31, ob = rr * 64 + cc * 2; return st * 1024 + (ob ^ (((ob >> 9) & 1) << 5)); }
__host__ __device__ __forceinline__ void stage_rc(int b, int& R, int& C) { const int st = b / 1024, sb = b % 1024, swz = sb ^ (((sb >> 9) & 1) << 5); R = (st >> 1) * 16 + swz / 64; C = (st & 1) * 32 + (swz % 64) / 2; }
__host__ __device__ __forceinline__ int perm32(int rho) { const int n = rho >> 4, i = rho & 15; return 8 * (i >> 2) + 4 * n + (i & 3); }

struct Unit { int pm, pn; };
struct Gemm { const bf16_t* A; const bf16_t* Bt; int M, N, K; };

struct StaticOrder {
    int nM, nN, nwg, G, c;
    __device__ void init(int M, int N, int G_, int c_) { nM = M / BM; nN = N / BM; nwg = nM * nN; G = G_; c = c_; }
    __device__ bool next(int i, Unit& u) const {
        const long L = (long)i * G + c; if (L >= nwg) return false;
        int wgid = (int)L; { const int q = nwg / NXCD, r = nwg % NXCD, xcd = wgid % NXCD, off = wgid / NXCD; wgid = (xcd < r ? xcd * (q + 1) : r * (q + 1) + (xcd - r) * q) + off; }
        const int nig = WGM * nN, gid = wgid / nig, fm = gid * WGM, gsz = (nM - fm) < WGM ? (nM - fm) : WGM;
        u.pm = fm + ((wgid % nig) % gsz); u.pn = (wgid % nig) / gsz; return true;
    }
};


struct EpiF32 {
    static constexpr bool PERM = false;
    float* O; int ldc;
    __device__ __forceinline__ void operator()(const f32x4 (&acc)[2][2][4][2], const Unit& u, int wr, int wc, int fr, int fq) const {
        const int row0 = u.pm * BM + wr * 64 + fr, col0 = u.pn * BM + wc * 32 + 4 * fq;
#pragma unroll
        for (int ai = 0; ai < 2; ++ai)
#pragma unroll
            for (int m = 0; m < 4; ++m) { float* rowp = O + (size_t)(row0 + ai * HALF + m * 16) * ldc + col0;
#pragma unroll
                for (int bj = 0; bj < 2; ++bj)
#pragma unroll
                    for (int n = 0; n < 2; ++n) *(f32x4*)(rowp + bj * HALF + n * 16) = acc[ai][bj][m][n]; }
    }
};
struct EpiLat {
    static constexpr bool PERM = false;
    bf16_t* CQ; bf16_t* CKV; bf16_t* KR; const float* qn; const float* kvn; const f32x2* rope; LAS float* xch;
    __device__ __forceinline__ void operator()(const f32x4 (&acc)[2][2][4][2], const Unit& u, int wr, int wc, int fr, int fq) const {
        const bool is_q = (u.pn == 0);
        LAS float* xw = xch + ((wr * 64 + fr) * 16 + wc * 4 + fq); const LAS float* xr = xch + (wr * 64 + fr) * 16;
#pragma unroll
        for (int ai = 0; ai < 2; ++ai)
#pragma unroll
            for (int m = 0; m < 4; ++m) { float sq = 0.f;
#pragma unroll
                for (int n = 0; n < 2; ++n) { const f32x4 x = acc[ai][0][m][n]; sq += (x[0] * x[0] + x[1] * x[1]) + (x[2] * x[2] + x[3] * x[3]); }
                if (is_q) {
#pragma unroll
                    for (int n = 0; n < 2; ++n) { const f32x4 x = acc[ai][1][m][n]; sq += (x[0] * x[0] + x[1] * x[1]) + (x[2] * x[2] + x[3] * x[3]); } }
                xw[(ai * HALF + m * 16) * 16] = sq; }
        asm volatile("s_waitcnt lgkmcnt(0)\n\ts_barrier" ::: "memory");
        const int col0 = wc * 32 + 4 * fq;
        if (is_q) {
#pragma unroll
            for (int ai = 0; ai < 2; ++ai)
#pragma unroll
                for (int m = 0; m < 4; ++m) { const int rl = ai * HALF + wr * 64 + m * 16 + fr; bf16_t* op = CQ + ((size_t)u.pm * BM + rl) * 256 + col0;
                    float tot = 0.f;
#pragma unroll
                    for (int q4 = 0; q4 < 4; ++q4) { const f32x4 pr = *(const LAS f32x4*)(xr + (ai * HALF + m * 16) * 16 + q4 * 4); tot += (pr[0] + pr[1]) + (pr[2] + pr[3]); }
                    const float rstd = __builtin_amdgcn_rsqf(tot * (1.f / 256.f) + RMS_EPS);
#pragma unroll
                    for (int bj = 0; bj < 2; ++bj)
#pragma unroll
                        for (int n = 0; n < 2; ++n) { const f32x4 g = *(const f32x4*)(qn + bj * HALF + col0 + n * 16); const f32x4 v = acc[ai][bj][m][n] * rstd * g;
                            u32x2 w; w.x = cvt_pk_bf16(v[0], v[1]); w.y = cvt_pk_bf16(v[2], v[3]); *(u32x2*)(op + bj * HALF + n * 16) = w; }
                    asm volatile("" ::: "memory"); }
        } else {
#pragma unroll
            for (int ai = 0; ai < 2; ++ai)
#pragma unroll
                for (int m = 0; m < 4; ++m) { const int rl = ai * HALF + wr * 64 + m * 16 + fr; const size_t row = (size_t)u.pm * BM + rl;
                    float tot = 0.f;
#pragma unroll
                    for (int q4 = 0; q4 < 4; ++q4) { const f32x4 pr = *(const LAS f32x4*)(xr + (ai * HALF + m * 16) * 16 + q4 * 4); tot += (pr[0] + pr[1]) + (pr[2] + pr[3]); }
                    const float rstd = __builtin_amdgcn_rsqf(tot * (1.f / 128.f) + RMS_EPS);
#pragma unroll
                    for (int n = 0; n < 2; ++n) { const f32x4 g = *(const f32x4*)(kvn + col0 + n * 16); const f32x4 v = acc[ai][0][m][n] * rstd * g;
                        u32x2 w; w.x = cvt_pk_bf16(v[0], v[1]); w.y = cvt_pk_bf16(v[2], v[3]); *(u32x2*)(CKV + row * 128 + col0 + n * 16) = w; }
                    if (wc == 0) { const f32x4* rp = (const f32x4*)(rope + (size_t)tok_pos((int)row) * 16 + 4 * fq); const f32x4 cs0 = rp[0], cs1 = rp[1];
                        const f32x4 c = {cs0[0], cs0[2], cs1[0], cs1[2]}, sn = {cs0[1], cs0[3], cs1[1], cs1[3]};
                        const f32x4 x1 = acc[ai][1][m][0], x2 = acc[ai][1][m][1]; const f32x4 o1 = x1 * c - x2 * sn, o2 = x2 * c + x1 * sn;
                        u32x2 w1, w2; w1.x = cvt_pk_bf16(o1[0], o1[1]); w1.y = cvt_pk_bf16(o1[2], o1[3]); w2.x = cvt_pk_bf16(o2[0], o2[1]); w2.y = cvt_pk_bf16(o2[2], o2[3]);
                        *(u32x2*)(KR + row * 32 + 4 * fq) = w1; *(u32x2*)(KR + row * 32 + 16 + 4 * fq) = w2; }
                    asm volatile("" ::: "memory"); }
        }
        asm volatile("s_waitcnt lgkmcnt(0)\n\ts_barrier" ::: "memory");
    }
};
struct EpiBf16S {
    static constexpr bool PERM = true;
    bf16_t* O; int ldc; int scale_cols; float scale0;
    __device__ __forceinline__ void operator()(const f32x4 (&acc)[2][2][4][2], const Unit& u, int wr, int wc, int fr, int fq) const {
        const int row0 = u.pm * BM + wr * 64 + fr, col0 = u.pn * BM + wc * 32 + 8 * fq;
        const float sc = (u.pn * BM < scale_cols) ? scale0 : 1.f;
#pragma unroll
        for (int ai = 0; ai < 2; ++ai)
#pragma unroll
            for (int m = 0; m < 4; ++m) { bf16_t* rowp = O + (size_t)(row0 + ai * HALF + m * 16) * ldc + col0;
#pragma unroll
                for (int bj = 0; bj < 2; ++bj) { const f32x4 v0 = acc[ai][bj][m][0] * sc, v1 = acc[ai][bj][m][1] * sc;
                    u32x4 w; w.x = cvt_pk_bf16(v0[0], v0[1]); w.y = cvt_pk_bf16(v0[2], v0[3]); w.z = cvt_pk_bf16(v1[0], v1[1]); w.w = cvt_pk_bf16(v1[2], v1[3]);
                    *(u32x4*)(rowp + bj * HALF) = w; } }
    }
};
struct EpiSwiGLU {
    static constexpr bool PERM = true;
    bf16_t* O;
    __device__ __forceinline__ void operator()(const f32x4 (&acc)[2][2][4][2], const Unit& u, int wr, int wc, int fr, int fq) const {
        const int row0 = u.pm * BM + wr * 64 + fr, col0 = u.pn * HALF + wc * 32 + 8 * fq;
#pragma unroll
        for (int ai = 0; ai < 2; ++ai)
#pragma unroll
            for (int m = 0; m < 4; ++m) { bf16_t* rowp = O + (size_t)(row0 + ai * HALF + m * 16) * FF + col0;
                float v[8];
#pragma unroll
                for (int n = 0; n < 2; ++n)
#pragma unroll
                    for (int i = 0; i < 4; ++i) { const float g = acc[ai][0][m][n][i], up = acc[ai][1][m][n][i];
                        v[n * 4 + i] = g * __builtin_amdgcn_rcpf(1.f + __builtin_amdgcn_exp2f(-g * LOG2E)) * up; }
                u32x4 w; w.x = cvt_pk_bf16(v[0], v[1]); w.y = cvt_pk_bf16(v[2], v[3]); w.z = cvt_pk_bf16(v[4], v[5]); w.w = cvt_pk_bf16(v[6], v[7]);
                *(u32x4*)rowp = w; }
    }
};

template <class Epi>
__device__ __forceinline__ void gemm_phase(LAS unsigned char* lds, const Gemm g, const StaticOrder& S, const Epi& E, const int tid) {
    const int wid = __builtin_amdgcn_readfirstlane(tid >> 6), lane = tid & 63, wr = wid >> 2, wc = wid & 3, fr = lane & 15, fq = lane >> 4;
    const int K = g.K, nt = K / BK;
    unsigned voffA[2], voffB[2];
#pragma unroll
    for (int i = 0; i < 2; ++i) { int R, C; stage_rc(tid * 16 + i * 8192, R, C); const int Rb = Epi::PERM ? ((R & ~31) + perm32(R & 31)) : R;
        voffA[i] = (unsigned)(R * K + C) * 2u; voffB[i] = (unsigned)(Rb * K + C) * 2u; }
    const size_t kstep = (size_t)(BK * 2);
    const size_t hstep = (size_t)HALF * K * 2;
    const size_t tstep = 2 * hstep;
    const unsigned ldsw = (unsigned)wid * 1024u;
    const int aoff = lds_byte(wr * 64 + fr, fq * 8), boff = lds_byte(wc * 32 + fr, fq * 8);
#define PG8_SA(b, h) (((b) * 2 + (h)) * HTB)
#define PG8_SB(b, h) ((4 + (b) * 2 + (h)) * HTB)
#define PG8_STAGE(bufoff, gbase, voff) do { _Pragma("unroll") for (int _i = 0; _i < 2; ++_i) \
        __builtin_amdgcn_global_load_lds((const unsigned*)((const char*)(gbase) + (voff)[_i]), (LAS unsigned*)(lds + (bufoff) + ldsw + _i * 8192), 16, 0, 0); } while (0)
#define PG8_LDA(dst, b, h) do { _Pragma("unroll") for (int m = 0; m < 4; ++m) _Pragma("unroll") for (int k = 0; k < 2; ++k) dst[m][k] = *(const LAS bf16x8*)(lds + PG8_SA(b, h) + aoff + m * 2048 + k * 1024); } while (0)
#define PG8_LDB(dst, b, h) do { _Pragma("unroll") for (int n = 0; n < 2; ++n) _Pragma("unroll") for (int k = 0; k < 2; ++k) dst[n][k] = *(const LAS bf16x8*)(lds + PG8_SB(b, h) + boff + n * 2048 + k * 1024); } while (0)
#define PG8_MMA(ai, bj, At, Bt) do { __builtin_amdgcn_s_setprio(1); _Pragma("unroll") for (int m = 0; m < 4; ++m) _Pragma("unroll") for (int n = 0; n < 2; ++n) _Pragma("unroll") for (int k = 0; k < 2; ++k) \
        acc[ai][bj][m][n] = __builtin_amdgcn_mfma_f32_16x16x32_bf16(Bt[n][k], At[m][k], acc[ai][bj][m][n], 0, 0, 0); __builtin_amdgcn_s_setprio(0); } while (0)
#define PG8_WAIT_V(n) asm volatile("s_waitcnt vmcnt(" #n ")" ::: "memory")
#define PG8_WAIT_L(n) asm volatile("s_waitcnt lgkmcnt(" #n ")" ::: "memory")
#define PG8_BAR __builtin_amdgcn_s_barrier()
#define PG8_SCHED __builtin_amdgcn_sched_barrier(0)
    Unit cur, nxt; int ui = 0;
    if (!S.next(0, cur)) return;
    f32x4 acc[2][2][4][2];
#pragma unroll
    for (int a = 0; a < 2; ++a)
#pragma unroll
        for (int b = 0; b < 2; ++b)
#pragma unroll
            for (int m = 0; m < 4; ++m)
#pragma unroll
                for (int n = 0; n < 2; ++n) acc[a][b][m][n] = (f32x4){0.f, 0.f, 0.f, 0.f};
    bf16x8 At[4][2], B0[2][2], B1[2][2];
    const char* cA = (const char*)g.A + (size_t)cur.pm * tstep; const char* cB = (const char*)g.Bt + (size_t)cur.pn * tstep;
    PG8_STAGE(PG8_SB(0, 0), cB, voffB); PG8_STAGE(PG8_SB(0, 1), cB + hstep, voffB); PG8_STAGE(PG8_SA(0, 0), cA, voffA); PG8_STAGE(PG8_SA(0, 1), cA + hstep, voffA);
    if (wr == 1) PG8_BAR;
    PG8_WAIT_V(2); PG8_BAR;
    PG8_STAGE(PG8_SB(1, 0), cB + kstep, voffB); PG8_STAGE(PG8_SA(1, 0), cA + kstep, voffA); PG8_STAGE(PG8_SB(1, 1), cB + hstep + kstep, voffB);
    PG8_WAIT_V(6); PG8_BAR;
    for (;;) {
        const bool has_next = S.next(ui + 1, nxt);
        const char* nA = has_next ? (const char*)g.A + (size_t)nxt.pm * tstep : cA; const char* nB = has_next ? (const char*)g.Bt + (size_t)nxt.pn * tstep : cB;
        for (int t = 0; t < nt; t += 2) {
            const bool last = (t == nt - 2);
            const char* a1 = cA + (size_t)(t + 1) * kstep;
            const char* a2 = last ? nA : cA + (size_t)(t + 2) * kstep; const char* b2 = last ? nB : cB + (size_t)(t + 2) * kstep;
            const char* a3 = a2 + kstep; const char* b3 = b2 + kstep;
            PG8_LDB(B0, 0, 0); PG8_LDB(B1, 0, 1); PG8_SCHED; PG8_LDA(At, 0, 0); PG8_STAGE(PG8_SA(1, 1), a1 + hstep, voffA);
            PG8_WAIT_V(8); PG8_WAIT_L(0); PG8_BAR; PG8_MMA(0, 0, At, B0); PG8_MMA(0, 1, At, B1); PG8_BAR; PG8_SCHED;
            PG8_LDA(At, 0, 1); PG8_STAGE(PG8_SB(0, 0), b2, voffB); PG8_STAGE(PG8_SB(0, 1), b2 + hstep, voffB); PG8_STAGE(PG8_SA(0, 0), a2, voffA);
            PG8_WAIT_V(8); PG8_WAIT_L(0); PG8_BAR; PG8_MMA(1, 0, At, B0); PG8_MMA(1, 1, At, B1); PG8_BAR; PG8_SCHED;
            PG8_LDB(B0, 1, 0); PG8_LDB(B1, 1, 1); PG8_SCHED; PG8_LDA(At, 1, 0); PG8_STAGE(PG8_SA(0, 1), a2 + hstep, voffA);
            PG8_WAIT_V(8); PG8_WAIT_L(0); PG8_BAR; PG8_MMA(0, 0, At, B0); PG8_MMA(0, 1, At, B1); PG8_BAR; PG8_SCHED;
            PG8_LDA(At, 1, 1); PG8_STAGE(PG8_SB(1, 0), b3, voffB); PG8_STAGE(PG8_SB(1, 1), b3 + hstep, voffB); PG8_STAGE(PG8_SA(1, 0), a3, voffA);
            PG8_WAIT_V(8); PG8_WAIT_L(0); PG8_BAR; PG8_MMA(1, 0, At, B0); PG8_MMA(1, 1, At, B1); PG8_BAR; PG8_SCHED;
        }
        if (wr == 0) PG8_BAR;
        E(acc, cur, wr, wc, fr, fq);
        if (!has_next) break;
#pragma unroll
        for (int a = 0; a < 2; ++a)
#pragma unroll
            for (int b = 0; b < 2; ++b)
#pragma unroll
                for (int m = 0; m < 4; ++m)
#pragma unroll
                    for (int n = 0; n < 2; ++n) acc[a][b][m][n] = (f32x4){0.f, 0.f, 0.f, 0.f};
        cur = nxt; cA = nA; cB = nB; ++ui;
        if (wr == 1) PG8_BAR;
    }
    PG8_WAIT_V(0);
    PG8_BAR;
#undef PG8_SA
#undef PG8_SB
#undef PG8_STAGE
#undef PG8_LDA
#undef PG8_LDB
#undef PG8_MMA
#undef PG8_WAIT_V
#undef PG8_WAIT_L
#undef PG8_BAR
#undef PG8_SCHED
}
}

#define SBAR() __builtin_amdgcn_sched_barrier(0)
#define KSWZ(row, colB) ((row) * 256 + ((colB) ^ (((row) & 7) << 4)))
__device__ __forceinline__ int crow(int r, int hi) { return (r & 3) + 8 * (r >> 2) + 4 * hi; }
constexpr float SM_THR = 8.f;

__device__ __forceinline__ void partialSM(f32x16& p0, f32x16& p1, float& m_reg, float& mn, float& alpha) {
    float pmax = p0[0];
#pragma unroll
    for (int r = 1; r < 16; ++r) pmax = fmaxf(pmax, p0[r]);
#pragma unroll
    for (int r = 0; r < 16; ++r) pmax = fmaxf(pmax, p1[r]);
    { auto rr = __builtin_amdgcn_permlane32_swap(__float_as_uint(pmax), __float_as_uint(pmax), false, false);
      pmax = fmaxf(__uint_as_float(rr[0]), __uint_as_float(rr[1])); }
    if (__builtin_expect(__all(pmax - m_reg <= SM_THR), 1)) { mn = m_reg; alpha = 1.f; }
    else { mn = fmaxf(m_reg, pmax); alpha = __builtin_amdgcn_exp2f(m_reg - mn); m_reg = mn; }
#pragma unroll
    for (int r = 0; r < 16; ++r) p0[r] -= mn;
#pragma unroll
    for (int r = 0; r < 16; ++r) p1[r] -= mn;
#pragma unroll
    for (int r = 0; r < 16; ++r) p0[r] = __builtin_amdgcn_exp2f(p0[r]);
}
__device__ __forceinline__ void finishSM(f32x16& p0, f32x16& p1, float alpha, float& l_reg, bf16x8& pa0, bf16x8& pa1, bf16x8& pa2, bf16x8& pa3) {
#pragma unroll
    for (int r = 0; r < 16; ++r) p1[r] = __builtin_amdgcn_exp2f(p1[r]);
    float ps = 0;
#pragma unroll
    for (int r = 0; r < 16; ++r) ps += p0[r];
#pragma unroll
    for (int r = 0; r < 16; ++r) ps += p1[r];
    { auto rr = __builtin_amdgcn_permlane32_swap(__float_as_uint(ps), __float_as_uint(ps), false, false);
      ps = __uint_as_float(rr[0]) + __uint_as_float(rr[1]); }
    l_reg = l_reg * alpha + ps;
#define PK4(P, BASE, OUT) do { unsigned a0 = cvt_pk_bf16(P[BASE + 0], P[BASE + 1]), a1 = cvt_pk_bf16(P[BASE + 2], P[BASE + 3]);   \
    unsigned b0 = cvt_pk_bf16(P[BASE + 4], P[BASE + 5]), b1 = cvt_pk_bf16(P[BASE + 6], P[BASE + 7]);                              \
    auto r0 = __builtin_amdgcn_permlane32_swap(a0, b0, false, false); auto r1 = __builtin_amdgcn_permlane32_swap(a1, b1, false, false); \
    u32x4 w = {r0[0], r1[0], r0[1], r1[1]}; OUT = *reinterpret_cast<bf16x8*>(&w); } while (0)
    PK4(p0, 0, pa0); PK4(p0, 8, pa1); PK4(p1, 0, pa2); PK4(p1, 8, pa3);
#undef PK4
}
__device__ __forceinline__ int v_st(int k, int c) { const int kk = (k & ~0xC) | ((k & 4) << 1) | ((k & 8) >> 1); return ((kk >> 3) * 2 + (c >> 5)) * 512 + ((kk & 7) * 32 + (c & 31)) * 2; }
__device__ __forceinline__ int v_st_nat(int k, int c) { return ((k >> 3) * 2 + (c >> 5)) * 512 + ((k & 7) * 32 + (c & 31)) * 2; }
__device__ __forceinline__ int v_rd_base(int lane) { return ((lane & 3) << 3) | (((lane >> 2) & 3) << 6) | (((lane >> 4) & 1) << 5) | (((lane >> 5) & 1) << 8); }
constexpr int v_rd_off(int d0, int ks, int half) { return d0 * 512 + ks * 2048 + half * 1024; }
template <int OFF> __device__ __forceinline__ s16x4 tr_read(int vb) {
    s16x4 r; asm volatile("ds_read_b64_tr_b16 %0, %1 offset:%2" : "=&v"(r) : "v"(vb), "i"(OFF) : "memory"); return r;
}
template <int D0> __device__ __forceinline__ void pv_one(f32x16& od, int vb, bf16x8 pa0, bf16x8 pa1, bf16x8 pa2, bf16x8 pa3) {
    const s16x4 l0 = tr_read<v_rd_off(D0, 0, 0)>(vb), h0 = tr_read<v_rd_off(D0, 0, 1)>(vb), l1 = tr_read<v_rd_off(D0, 1, 0)>(vb), h1 = tr_read<v_rd_off(D0, 1, 1)>(vb);
    const s16x4 l2 = tr_read<v_rd_off(D0, 2, 0)>(vb), h2 = tr_read<v_rd_off(D0, 2, 1)>(vb), l3 = tr_read<v_rd_off(D0, 3, 0)>(vb), h3 = tr_read<v_rd_off(D0, 3, 1)>(vb);
    asm volatile("s_waitcnt lgkmcnt(0)" ::: "memory"); SBAR();
#define PK(L, H) (bf16x8){L[0], L[1], L[2], L[3], H[0], H[1], H[2], H[3]}
    od = __builtin_amdgcn_mfma_f32_32x32x16_bf16(pa0, PK(l0, h0), od, 0, 0, 0);
    od = __builtin_amdgcn_mfma_f32_32x32x16_bf16(pa1, PK(l1, h1), od, 0, 0, 0);
    od = __builtin_amdgcn_mfma_f32_32x32x16_bf16(pa2, PK(l2, h2), od, 0, 0, 0);
    od = __builtin_amdgcn_mfma_f32_32x32x16_bf16(pa3, PK(l3, h3), od, 0, 0, 0);
#undef PK
}
__device__ __forceinline__ void pv2(f32x16* o, int vb, bf16x8 pa0, bf16x8 pa1, bf16x8 pa2, bf16x8 pa3) {
    pv_one<0>(o[0], vb, pa0, pa1, pa2, pa3); pv_one<1>(o[1], vb, pa0, pa1, pa2, pa3);
}

namespace mla {
constexpr int KROW = 272, SHM_V = 8192, SHM_K = 64 * KROW, NSLOT = 3, OFF_V = 0, OFF_K = NSLOT * SHM_V, OFF_WS = OFF_K + NSLOT * SHM_K;
constexpr int QROW = 208, OFF_Q = OFF_WS + 2048, Q_WAVE = 32 * QROW;
struct VFrag { s16x4 l[2][4], h[2][4]; };
__device__ __forceinline__ void vread(VFrag& f, int vb) {
#define VR(D0, KS) f.l[D0][KS] = tr_read<v_rd_off(D0, KS, 0)>(vb); f.h[D0][KS] = tr_read<v_rd_off(D0, KS, 1)>(vb)
    VR(0, 0); VR(0, 1); VR(0, 2); VR(0, 3); VR(1, 0); VR(1, 1); VR(1, 2); VR(1, 3);
#undef VR
}
template <int B_> __device__ __forceinline__ void kread(bf16x8* kf, bf16x8* qf, const char* kb, const char* qb) {
#pragma unroll
    for (int i = 0; i < 2; ++i) { kf[2 * i] = *reinterpret_cast<const bf16x8*>(kb + (2 * B_ + i) * 32); kf[2 * i + 1] = *reinterpret_cast<const bf16x8*>(kb + 32 * KROW + (2 * B_ + i) * 32);
        qf[i] = *reinterpret_cast<const bf16x8*>(qb + (2 * B_ + i) * 32); }
}
template <int D0> __device__ __forceinline__ void pv_mma(f32x16& od, const VFrag& f, bf16x8 pa0, bf16x8 pa1, bf16x8 pa2, bf16x8 pa3) {
#define PK(L, H) (bf16x8){L[0], L[1], L[2], L[3], H[0], H[1], H[2], H[3]}
    od = __builtin_amdgcn_mfma_f32_32x32x16_bf16(pa0, PK(f.l[D0][0], f.h[D0][0]), od, 0, 0, 0);
    od = __builtin_amdgcn_mfma_f32_32x32x16_bf16(pa1, PK(f.l[D0][1], f.h[D0][1]), od, 0, 0, 0);
    od = __builtin_amdgcn_mfma_f32_32x32x16_bf16(pa2, PK(f.l[D0][2], f.h[D0][2]), od, 0, 0, 0);
    od = __builtin_amdgcn_mfma_f32_32x32x16_bf16(pa3, PK(f.l[D0][3], f.h[D0][3]), od, 0, 0, 0);
#undef PK
}
#define MLA_BAR() asm volatile("s_waitcnt lgkmcnt(0)\n\ts_barrier" ::: "memory")
#define LWAIT() do { asm volatile("s_waitcnt lgkmcnt(0)" ::: "memory"); SBAR(); } while (0)
__device__ __forceinline__ void unit(const bf16_t* __restrict__ Qg, const bf16_t* __restrict__ KVg, const bf16_t* __restrict__ KRg, bf16_t* __restrict__ Og, const f32x2* __restrict__ rope,
                                     int tok0, int seq, int h, int qb, char* lds, const int tid) {
    const int wid = __builtin_amdgcn_readfirstlane(tid >> 6), lane = tid & 63, r32 = lane & 31, hi = lane >> 5;
    const int grp = wid >> 2;
    char* V_lds = lds + OFF_V; char* K_lds = lds + OFF_K;
    float* al_l = (float*)(lds + OFF_WS) + wid * 64;
    f32x16 o[3]; o[0] = f32x16{}; o[1] = f32x16{}; o[2] = f32x16{}; bf16x8 qr[6];
    f32x16 negm = f32x16{};
    const bf16_t* Qw = Qg + (size_t)(tok0 + qb * 256 + wid * 32 + r32) * NQ + h * 96 + hi * 8;
#pragma unroll
    for (int d0 = 0; d0 < 6; ++d0) qr[d0] = *reinterpret_cast<const bf16x8*>(Qw + d0 * 16);
    {
        const f32x4* rp = (const f32x4*)(rope + (size_t)(qb * 256 + wid * 32 + r32) * 16 + 8 * hi);
        u32x4 a = *reinterpret_cast<u32x4*>(&qr[4]), b = *reinterpret_cast<u32x4*>(&qr[5]);
#pragma unroll
        for (int p = 0; p < 4; ++p) { const f32x4 cs = rp[p];
            const float x1a = bf_lo(a[p]), x1b = bf_hi(a[p]), x2a = bf_lo(b[p]), x2b = bf_hi(b[p]);
            a[p] = cvt_pk_bf16(x1a * cs[0] - x2a * cs[1], x1b * cs[2] - x2b * cs[3]);
            b[p] = cvt_pk_bf16(x2a * cs[0] + x1a * cs[1], x2b * cs[2] + x1b * cs[3]); }
        qr[4] = *reinterpret_cast<bf16x8*>(&a); qr[5] = *reinterpret_cast<bf16x8*>(&b);
    }
    char* qbw = lds + OFF_Q + wid * Q_WAVE + r32 * QROW + hi * 16;
#pragma unroll
    for (int d0 = 0; d0 < 6; ++d0) *reinterpret_cast<bf16x8*>(qbw + d0 * 32) = qr[d0];
    const char* qb_ = qbw;
    const int srow = tid >> 3, sc = (tid & 7) * 8;
    const bf16_t* kvp = KVg + (size_t)(tok0 + srow) * NKV + h * 128 + sc;
    const int rrow = (tid >> 2) & 63, rc = (tid & 3) * 8;
    const bf16_t* krp = KRg + (size_t)(tok0 + rrow) * 32 + rc;
    const int vst = v_st_nat(srow, sc), kst = srow * KROW + sc * 2, rst = rrow * KROW + (64 + rc) * 2;
    const bool do_r = wid < 4;
    const int vb0 = (int)(uintptr_t)V_lds + v_rd_base(lane);
    const char* kb0 = K_lds + r32 * KROW + hi * 16;
    const u32x4 ones_u = {0x3f803f80u, 0x3f803f80u, 0x3f803f80u, 0x3f803f80u}; const bf16x8 ones = *reinterpret_cast<const bf16x8*>(&ones_u);
    bf16x8 sv, sk, sr; sr = bf16x8{};
#define SLOAD(k0) do { sv = *reinterpret_cast<const bf16x8*>(kvp + (size_t)(k0) * NKV + 64); sk = *reinterpret_cast<const bf16x8*>(kvp + (size_t)(k0) * NKV); if (do_r) sr = *reinterpret_cast<const bf16x8*>(krp + (size_t)(k0) * 32); } while (0)
#define SWRITE(s) do { *(bf16x8*)(V_lds + (s) * SHM_V + vst) = sv; *(bf16x8*)(K_lds + (s) * SHM_K + kst) = sk; if (do_r) *(bf16x8*)(K_lds + (s) * SHM_K + rst) = sr; } while (0)
#define SOFTMAX_Y(FIRST) do { \
    float rm; {   \
      float ca = fmaxf(fmaxf(p0[0], p0[1]), p0[2]), cb = fmaxf(fmaxf(p0[8], p0[9]), p0[10]), cc = fmaxf(fmaxf(p1[0], p1[1]), p1[2]), cd = fmaxf(fmaxf(p1[8], p1[9]), p1[10]); \
      ca = fmaxf(fmaxf(ca, p0[3]), p0[4]); cb = fmaxf(fmaxf(cb, p0[11]), p0[12]); cc = fmaxf(fmaxf(cc, p1[3]), p1[4]); cd = fmaxf(fmaxf(cd, p1[11]), p1[12]); \
      ca = fmaxf(fmaxf(ca, p0[5]), p0[6]); cb = fmaxf(fmaxf(cb, p0[13]), p0[14]); cc = fmaxf(fmaxf(cc, p1[5]), p1[6]); cd = fmaxf(fmaxf(cd, p1[13]), p1[14]); \
      ca = fmaxf(ca, p0[7]); cb = fmaxf(cb, p0[15]); cc = fmaxf(cc, p1[7]); cd = fmaxf(cd, p1[15]); \
      rm = fmaxf(fmaxf(fmaxf(ca, cb), cc), cd); } \
    { auto rr_ = __builtin_amdgcn_permlane32_swap(__float_as_uint(rm), __float_as_uint(rm), false, false); rm = fmaxf(__uint_as_float(rr_[0]), __uint_as_float(rr_[1])); } \
    if ((FIRST) || __any(rm > SM_THR)) { \
        const float dl = (FIRST) ? rm : fmaxf(rm, 0.f); \
        _Pragma("unroll") for (int r = 0; r < 16; ++r) { p0[r] -= dl; p1[r] -= dl; negm[r] -= dl; } \
        if (!(FIRST)) { const float al_ = __builtin_amdgcn_exp2f(-dl); if (hi == 0) al_l[r32] = al_; asm volatile("s_waitcnt lgkmcnt(0)" ::: "memory"); \
            _Pragma("unroll") for (int d = 0; d < 3; ++d) _Pragma("unroll") for (int r = 0; r < 16; ++r) o[d][r] *= al_l[crow(r, hi)]; } \
    } \
    _Pragma("unroll") for (int r = 0; r < 16; ++r) { p0[r] = __builtin_amdgcn_exp2f(p0[r]); p1[r] = __builtin_amdgcn_exp2f(p1[r]); } \
    PK4_(p0, 0, pa0); PK4_(p0, 8, pa1); PK4_(p1, 0, pa2); PK4_(p1, 8, pa3); } while (0)
#define PK4_(P, BASE, OUT) do { u32x4 w = {cvt_pk_bf16(P[BASE + 0], P[BASE + 1]), cvt_pk_bf16(P[BASE + 2], P[BASE + 3]), cvt_pk_bf16(P[BASE + 4], P[BASE + 5]), cvt_pk_bf16(P[BASE + 6], P[BASE + 7])}; \
    OUT = *reinterpret_cast<bf16x8*>(&w); } while (0)
#define QKA() do { p0 = __builtin_amdgcn_mfma_f32_32x32x16_bf16(kf[0], qf[0], negm, 0, 0, 0); p1 = __builtin_amdgcn_mfma_f32_32x32x16_bf16(kf[1], qf[0], negm, 0, 0, 0); \
    p0 = __builtin_amdgcn_mfma_f32_32x32x16_bf16(kf[2], qf[1], p0, 0, 0, 0); p1 = __builtin_amdgcn_mfma_f32_32x32x16_bf16(kf[3], qf[1], p1, 0, 0, 0); } while (0)
#define QKB() do { p0 = __builtin_amdgcn_mfma_f32_32x32x16_bf16(kf[0], qf[0], p0, 0, 0, 0); p1 = __builtin_amdgcn_mfma_f32_32x32x16_bf16(kf[1], qf[0], p1, 0, 0, 0); \
    p0 = __builtin_amdgcn_mfma_f32_32x32x16_bf16(kf[2], qf[1], p0, 0, 0, 0); p1 = __builtin_amdgcn_mfma_f32_32x32x16_bf16(kf[3], qf[1], p1, 0, 0, 0); } while (0)
#define ONES4() do { o[2] = __builtin_amdgcn_mfma_f32_32x32x16_bf16(pa0, ones, o[2], 0, 0, 0); o[2] = __builtin_amdgcn_mfma_f32_32x32x16_bf16(pa1, ones, o[2], 0, 0, 0); \
    o[2] = __builtin_amdgcn_mfma_f32_32x32x16_bf16(pa2, ones, o[2], 0, 0, 0); o[2] = __builtin_amdgcn_mfma_f32_32x32x16_bf16(pa3, ones, o[2], 0, 0, 0); } while (0)
    f32x16 p0, p1; bf16x8 pa0, pa1, pa2, pa3; const int NT = seq / 64;
    SLOAD(0); SWRITE(0); SLOAD(64); SWRITE(1); if (2 < NT) SLOAD(128);
    __syncthreads();
    if (grp) MLA_BAR();
    bf16x8 kf[4], qf[2]; VFrag vf;
    kread<0>(kf, qf, kb0, qb_); LWAIT(); QKA(); SBAR();
    kread<1>(kf, qf, kb0, qb_); LWAIT(); QKB(); SBAR();
    kread<2>(kf, qf, kb0, qb_); LWAIT(); QKB(); SBAR();
    MLA_BAR();
    vread(vf, vb0); SBAR();
    SOFTMAX_Y(true);
    MLA_BAR();
    int sv_ = 0, sk_ = 1, sw_ = 2;
#pragma unroll 1
    for (int t = 0; t + 1 < NT; ++t) {
        SBAR();
        if (grp) { if (t + 2 < NT) SWRITE(sw_); if (t + 3 < NT) SLOAD((t + 3) * 64); }
        const char* kb = kb0 + sk_ * SHM_K;
        __builtin_amdgcn_s_setprio(1);
        kread<0>(kf, qf, kb, qb_); SBAR();
        pv_mma<0>(o[0], vf, pa0, pa1, pa2, pa3); SBAR();
        LWAIT(); QKA(); SBAR();
        kread<1>(kf, qf, kb, qb_); SBAR();
        ONES4(); SBAR();
        LWAIT(); QKB(); SBAR();
        kread<2>(kf, qf, kb, qb_); SBAR();
        pv_mma<1>(o[1], vf, pa0, pa1, pa2, pa3); SBAR();
        LWAIT(); QKB(); SBAR();
        __builtin_amdgcn_s_setprio(0);
        MLA_BAR();
        vread(vf, vb0 + sk_ * SHM_V); SBAR();
        if (!grp) { if (t + 2 < NT) SWRITE(sw_); if (t + 3 < NT) SLOAD((t + 3) * 64); }
        SBAR();
        SOFTMAX_Y(false);
        SBAR();
        MLA_BAR();
        { const int tmp = sv_; sv_ = sk_; sk_ = sw_; sw_ = tmp; }
    }
    SBAR();
    pv_mma<0>(o[0], vf, pa0, pa1, pa2, pa3); pv_mma<1>(o[1], vf, pa0, pa1, pa2, pa3); ONES4();
    MLA_BAR();
    if (!grp) MLA_BAR();
    bf16_t* stg = (bf16_t*)K_lds + wid * 2048;
#pragma unroll
    for (int r = 0; r < 16; ++r) { const int orow = crow(r, hi); const float rl = __builtin_amdgcn_rcpf(o[2][r]);
#pragma unroll
        for (int d0 = 0; d0 < 2; ++d0) stg[orow * 64 + d0 * 32 + r32] = f2bf(o[d0][r] * rl); }
    asm volatile("s_waitcnt lgkmcnt(0)" ::: "memory");
    bf16_t* Ow = Og + (size_t)(tok0 + qb * 256 + wid * 32) * DM + h * 64;
#pragma unroll
    for (int i = 0; i < 4; ++i) { const int row = i * 8 + (lane >> 3), ch = lane & 7; const u32x4 v = *(const u32x4*)(stg + row * 64 + ch * 8); *(u32x4*)(Ow + (size_t)row * DM + ch * 8) = v; }
    __syncthreads();
#undef SLOAD
#undef SWRITE
#undef SOFTMAX_Y
#undef PK4_
#undef QKA
#undef QKB
#undef ONES4
}
__device__ __forceinline__ void phase(const bf16_t* Q, const bf16_t* KV, const bf16_t* KR, bf16_t* O, const f32x2* rope, char* lds, const int tid, const int b, const int G) {
    if (G == 256) {
        const int xcd = b & 7, c = b >> 3;
        for (int i = 0; i < 16; ++i) unit(Q, KV, KR, O, rope, xcd * 8192, 8192, i, c, lds, tid);
        for (int j = 0; j < 8; ++j) unit(Q, KV, KR, O, rope, TP + xcd * 4096, 4096, 2 * j + (c >> 4), c & 15, lds, tid);
    } else {
        for (int u = b; u < 4096 + 2048; u += G) {
            if (u < 4096) unit(Q, KV, KR, O, rope, (u >> 9) * 8192, 8192, (u >> 5) & 15, u & 31, lds, tid);
            else { const int v = u - 4096; unit(Q, KV, KR, O, rope, TP + (v >> 8) * 4096, 4096, (v >> 4) & 15, v & 15, lds, tid); }
        }
    }
}
}

namespace na {
constexpr int KRB = 144, SLOT_K = 128 * KRB, SLOT_V = 16384, SLOT = SLOT_K + SLOT_V, NSL = 3, OFF_BIAS = NSL * SLOT, OFF_WS = OFF_BIAS + 29760;
template <int OFF> __device__ __forceinline__ s16x4 trr(int vb) { s16x4 r; asm volatile("ds_read_b64_tr_b16 %0, %1 offset:%2" : "=&v"(r) : "v"(vb), "i"(OFF) : "memory"); return r; }
constexpr int vro(int d0, int ks, int half) { return d0 * 512 + half * 1024 + (ks & 1) * 2048 + (ks >> 1) * 8192; }
template <int D0> __device__ __forceinline__ void pv_blk(f32x16& od, int vb, bf16x8 pa0, bf16x8 pa1, bf16x8 pa2, bf16x8 pa3) {
    const s16x4 l0 = trr<vro(D0, 0, 0)>(vb), h0 = trr<vro(D0, 0, 1)>(vb), l1 = trr<vro(D0, 1, 0)>(vb), h1 = trr<vro(D0, 1, 1)>(vb);
    const s16x4 l2 = trr<vro(D0, 2, 0)>(vb), h2 = trr<vro(D0, 2, 1)>(vb), l3 = trr<vro(D0, 3, 0)>(vb), h3 = trr<vro(D0, 3, 1)>(vb);
    asm volatile("s_waitcnt lgkmcnt(0)" ::: "memory"); SBAR();
#define PK(L, H) (bf16x8){L[0], L[1], L[2], L[3], H[0], H[1], H[2], H[3]}
    od = __builtin_amdgcn_mfma_f32_32x32x16_bf16(pa0, PK(l0, h0), od, 0, 0, 0);
    od = __builtin_amdgcn_mfma_f32_32x32x16_bf16(pa1, PK(l1, h1), od, 0, 0, 0);
    od = __builtin_amdgcn_mfma_f32_32x32x16_bf16(pa2, PK(l2, h2), od, 0, 0, 0);
    od = __builtin_amdgcn_mfma_f32_32x32x16_bf16(pa3, PK(l3, h3), od, 0, 0, 0);
#undef PK
}
__device__ __forceinline__ void phase(const bf16_t* __restrict__ QKV, bf16_t* __restrict__ Og, const float* __restrict__ rpb, char* lds, const int tid, const int bid, const int G) {
    const int wid = __builtin_amdgcn_readfirstlane(tid >> 6), lane = tid & 63, r32 = lane & 31, hi = lane >> 5;
    float* bias = (float*)(lds + OFF_BIAS);
    for (int i = tid; i < 16 * 15 * 31; i += 512) bias[i] = rpb[i] * LOG2E;
    float* al_l = (float*)(lds + OFF_WS) + wid * 32;
    const int g = wid & 3, kc0 = min(max(16 * g - 8, 0), 32);
    const int qcol = 16 * g + (r32 & 15), cs = min(max(qcol - 8, 0), 48);
    const int tw = kc0 + 4 * hi - cs;
    const int kbw = (kc0 + r32) * KRB + hi * 16;
    const int vbw = (int)(uintptr_t)lds + SLOT_K + (kc0 >> 3) * 1024 + v_rd_base(lane);
    const int srho0 = tid >> 3, sdc = (tid & 7) * 8;
    const int kst0 = srho0 * KRB + sdc * 2, kst1 = (srho0 + 64) * KRB + sdc * 2;
    const int scol = srho0 & 63;
    const int vst0 = SLOT_K + (((srho0 >> 6) * 8 + (scol >> 3)) * 2 + (sdc >> 5)) * 512 + ((scol & 7) * 32 + (sdc & 31)) * 2, vst1 = vst0 + 8192;
    const int nunits = 6144, per = (nunits + G - 1) / G;
#pragma unroll 1
    for (int ii = 0; ii < per; ++ii) {
        int h, rg, rows, tokb;
        if (G == 256) {
            const int xcd = bid & 7, c = bid >> 3;
            if (ii < 16) { h = ii; rg = c; rows = 128; tokb = xcd * 8192; } else { h = 2 * (ii - 16) + (c >> 4); rg = c & 15; rows = 64; tokb = TP + xcd * 4096; }
        } else {
            const int u = bid * per + ii; if (u >= nunits) break;
            h = u & 15; int gg = u >> 4;
            if (gg < 256) { rg = gg & 31; rows = 128; tokb = (gg >> 5) * 8192; } else { gg -= 256; rg = gg & 15; rows = 64; tokb = TP + (gg >> 4) * 4096; }
        }
        const int r0 = rg * 4, rsb = min(max(r0 - 4, 0), rows - 8);
        const int r = r0 + 2 * (wid >> 2);
        const int rs0 = min(max(r - 4, 0), rows - 8), rs1 = min(max(r - 3, 0), rows - 8);
        const int toff = (rs0 - rsb) >> 1;
        const int ntile = 5 + ((min(max(r0 - 2, 0), rows - 8) - rsb) >> 1);
        const int qrow = r + ((r32 >> 4) & 1), rsq = (r32 & 16) ? rs1 : rs0;
        const bf16_t* qp = QKV + (size_t)(tokb + qrow * 64 + qcol) * 3072 + h * 64 + hi * 8;
        bf16x8 qr[4];
#pragma unroll
        for (int d0 = 0; d0 < 4; ++d0) qr[d0] = *reinterpret_cast<const bf16x8*>(qp + d0 * 16);
        const bf16_t* gbase = QKV + (size_t)tokb * 3072 + 1024 + h * 64 + (size_t)scol * 3072 + sdc;
        bf16x8 sk0, sk1, sv0, sv1;
#define NA_GLOAD(tau) do { const int ra_ = min(rsb + 2 * (tau), rows - 1), rb_ = min(rsb + 2 * (tau) + 1, rows - 1); \
            const bf16_t* pa_ = gbase + (size_t)ra_ * (64 * 3072); const bf16_t* pb_ = gbase + (size_t)rb_ * (64 * 3072); \
            sk0 = *reinterpret_cast<const bf16x8*>(pa_); sv0 = *reinterpret_cast<const bf16x8*>(pa_ + 1024); sk1 = *reinterpret_cast<const bf16x8*>(pb_); sv1 = *reinterpret_cast<const bf16x8*>(pb_ + 1024); } while (0)
#define NA_LWRITE(slot) do { char* sb_ = lds + (slot) * SLOT; *(bf16x8*)(sb_ + kst0) = sk0; *(bf16x8*)(sb_ + kst1) = sk1; *(bf16x8*)(sb_ + vst0) = sv0; *(bf16x8*)(sb_ + vst1) = sv1; } while (0)
        __syncthreads();
        NA_GLOAD(0); NA_LWRITE(0); NA_GLOAD(1); NA_LWRITE(1); NA_GLOAD(2);
        float m_reg = -1e30f, l_reg = 0.f; f32x16 o[2]; o[0] = f32x16{}; o[1] = f32x16{};
        const float* bh = bias + h * (15 * 31);
        int s0 = 0, s1 = 1, s2 = 2;
#pragma unroll 1
        for (int s = 0; s < 5; ++s) {
            __syncthreads();
            if (s + 2 < ntile) NA_LWRITE(s2);
            if (s + 3 < ntile) NA_GLOAD(s + 3);
            SBAR();
            const int slot = toff ? s1 : s0;
            const char* kb = lds + slot * SLOT + kbw;
            bf16x8 ka[8];
#pragma unroll
            for (int d0 = 0; d0 < 4; ++d0) { ka[d0] = *reinterpret_cast<const bf16x8*>(kb + d0 * 32); ka[4 + d0] = *reinterpret_cast<const bf16x8*>(kb + 64 * KRB + d0 * 32); }
            f32x16 p0 = f32x16{}, p1 = f32x16{};
#pragma unroll
            for (int d0 = 0; d0 < 4; ++d0) { p0 = __builtin_amdgcn_mfma_f32_32x32x16_bf16(ka[d0], qr[d0], p0, 0, 0, 0); p1 = __builtin_amdgcn_mfma_f32_32x32x16_bf16(ka[4 + d0], qr[d0], p1, 0, 0, 0); }
            const int kra = rs0 + 2 * s;
            const bool oka = (unsigned)(kra - rsq) < 8u, okb = (unsigned)(kra + 1 - rsq) < 8u;
            const float* bl = bh + (kra - qrow + 7) * 31 + (kc0 + 4 * hi - qcol + 15);
#pragma unroll
            for (int rr = 0; rr < 16; ++rr) { const int k0 = (rr & 3) + 8 * (rr >> 2); const bool okc = (unsigned)(tw + k0) < 16u;
                p0[rr] = (okc && oka) ? p0[rr] + bl[k0] : -1e30f;
                p1[rr] = (okc && okb) ? p1[rr] + bl[k0 + 31] : -1e30f; }
            float mn, alpha; partialSM(p0, p1, m_reg, mn, alpha);
#pragma unroll
            for (int rr = 0; rr < 16; ++rr) p1[rr] = __builtin_amdgcn_exp2f(p1[rr]);
            { float ps = 0.f;
#pragma unroll
              for (int rr = 0; rr < 16; ++rr) ps += p0[rr] + p1[rr];
              auto sw = __builtin_amdgcn_permlane32_swap(__float_as_uint(ps), __float_as_uint(ps), false, false); l_reg = l_reg * alpha + (__uint_as_float(sw[0]) + __uint_as_float(sw[1])); }
            bf16x8 pa0, pa1, pa2, pa3;
#define PKD(P, B, OUT) do { u32x4 w_ = {cvt_pk_bf16(P[B + 0], P[B + 1]), cvt_pk_bf16(P[B + 2], P[B + 3]), cvt_pk_bf16(P[B + 4], P[B + 5]), cvt_pk_bf16(P[B + 6], P[B + 7])}; OUT = *reinterpret_cast<bf16x8*>(&w_); } while (0)
            PKD(p0, 0, pa0); PKD(p0, 8, pa1); PKD(p1, 0, pa2); PKD(p1, 8, pa3);
#undef PKD
            if (__any(alpha < 1.f)) { if (hi == 0) al_l[r32] = alpha; asm volatile("s_waitcnt lgkmcnt(0)" ::: "memory");
#pragma unroll
                for (int d = 0; d < 2; ++d)
#pragma unroll
                    for (int rr = 0; rr < 16; ++rr) o[d][rr] *= al_l[crow(rr, hi)]; }
            SBAR();
            const int vb = vbw + slot * SLOT;
            pv_blk<0>(o[0], vb, pa0, pa1, pa2, pa3); pv_blk<1>(o[1], vb, pa0, pa1, pa2, pa3);
            { const int t_ = s0; s0 = s1; s1 = s2; s2 = t_; }
        }
#undef NA_GLOAD
#undef NA_LWRITE
        if (hi == 0) al_l[r32] = l_reg; asm volatile("s_waitcnt lgkmcnt(0)" ::: "memory");
        bf16_t* Ow = Og + (size_t)(tokb + r * 64 + 16 * g) * DM + h * 64;
#pragma unroll
        for (int rr = 0; rr < 16; ++rr) { const int q = crow(rr, hi); const float rl = __builtin_amdgcn_rcpf(al_l[q]); bf16_t* op = Ow + (size_t)((q >> 4) * 64 + (q & 15)) * DM + r32;
            op[0] = f2bf(o[0][rr] * rl); op[32] = f2bf(o[1][rr] * rl); }
        asm volatile("s_waitcnt lgkmcnt(0)" ::: "memory");
    }
}
}

#define XB_TMO      128
#define XB_XCNT(j)  (256  + 64 * (j))
#define XB_XSUB(j)  (1280 + 64 * (j))
#define XB_XGEN(j)  (2304 + 64 * (j))
#define XB_TOP      3328
#define XB_TOPGEN   3392
#define XCD_BAR_WORDS 3456
#define XB_SPIN_CAP (1u << 18)

__device__ __forceinline__ unsigned xb_ld(unsigned* p)              { return __hip_atomic_load(p, __ATOMIC_RELAXED, __HIP_MEMORY_SCOPE_AGENT); }
__device__ __forceinline__ unsigned xb_add(unsigned* p, unsigned v) { return __hip_atomic_fetch_add(p, v, __ATOMIC_RELAXED, __HIP_MEMORY_SCOPE_AGENT); }
__device__ __forceinline__ unsigned xb_xcc_id() { return (unsigned)__builtin_amdgcn_s_getreg((3 << 11) | 20) & 0xFu; }
#define XB_SPIN(cond, bar) do { unsigned _sp = 0; while (cond) { __builtin_amdgcn_s_sleep(1); \
    if ((++_sp & 255u) == 0u) { if (xb_ld(&(bar)[XB_TMO])) break; if (_sp > XB_SPIN_CAP) { atomicAdd(&(bar)[XB_TMO], 1u); break; } } } } while (0)

struct XcdBarrier {
    unsigned* bar; unsigned x;
    volatile LAS unsigned* st;
};

__device__ __forceinline__ XcdBarrier xcd_barrier_post(unsigned* bar, volatile LAS unsigned* st) {
    XcdBarrier b; b.bar = bar; b.x = xb_xcc_id(); b.st = st;
    if (threadIdx.x == 0) (void)xb_add(&bar[XB_XCNT(b.x)], 1u);
    return b;
}
__device__ __forceinline__ void xcd_barrier_complete(unsigned* bar, unsigned x, unsigned& nloc, unsigned& nx) {
    const unsigned G = gridDim.x * gridDim.y * gridDim.z;
    unsigned sum, cnt, mine, sp = 0u;
    for (;;) {
        sum = 0u; cnt = 0u; mine = 0u;
#pragma unroll
        for (unsigned j = 0; j < 16; ++j) { const unsigned c = xb_ld(&bar[XB_XCNT(j)]); sum += c; cnt += (c > 0u) ? 1u : 0u; mine = (j == x) ? c : mine; }
        if (sum == G) break;
        __builtin_amdgcn_s_sleep(1);
        if ((++sp & 255u) == 0u) { if (xb_ld(&bar[XB_TMO])) break; if (sp > XB_SPIN_CAP) { atomicAdd(&bar[XB_TMO], 1u); break; } }
    }
    nloc = mine > 0u ? mine : 1u; nx = cnt > 0u ? cnt : 1u;
}

__device__ __forceinline__ void xcd_barrier(const XcdBarrier& b) {
    asm volatile("s_waitcnt vmcnt(0)" ::: "memory");
    __syncthreads();
    if (threadIdx.x == 0) {
        unsigned* bar = b.bar;
        __builtin_amdgcn_s_waitcnt(0);
        unsigned nloc = b.st[0], nx = b.st[1];
        if (nloc == 0u) { xcd_barrier_complete(bar, b.x, nloc, nx); b.st[0] = nloc; b.st[1] = nx; }
        const unsigned old = xb_add(&bar[XB_XSUB(b.x)], 1u);
        const unsigned gen = old / nloc;
        if (old + 1u == (gen + 1u) * nloc) {
            __builtin_amdgcn_fence(__ATOMIC_RELEASE, "agent");
            asm volatile("s_waitcnt vmcnt(0)" ::: "memory");
            const unsigned og = xb_add(&bar[XB_TOP], 1u);
            const unsigned tg = og / nx;
            if (og + 1u == (tg + 1u) * nx) xb_add(&bar[XB_TOPGEN], 1u);
            else XB_SPIN(xb_ld(&bar[XB_TOPGEN]) == tg, bar);
            __builtin_amdgcn_fence(__ATOMIC_ACQUIRE, "agent");
            xb_add(&bar[XB_XGEN(b.x)], 1u);
            asm volatile("s_waitcnt vmcnt(0)" ::: "memory");
        } else {
            XB_SPIN(xb_ld(&bar[XB_XGEN(b.x)]) == gen, bar);
            __builtin_amdgcn_fence(__ATOMIC_ACQUIRE, "agent");
            asm volatile("s_waitcnt vmcnt(0)" ::: "memory");
        }
    }
    __syncthreads();
}


struct RowP { const float* xin0; const float* xin1; const bf16_t* h; const float* gpost; const float* gate; float* xout; bf16_t* hn; const float* g2; const float* scale; const float* shift; };
template <bool HAS_H, bool HAS_HN, bool XIN_BF, bool XOUT_BF>
__device__ __forceinline__ void rowpass(const RowP P, int gw, int ngw, int lane) {
    const int rpw = (T + ngw - 1) / ngw; const int r0 = gw * rpw, r1 = min(T, r0 + rpw);
    int cur_bb = -1; f32x4 A[4], B[4], C[4];
#pragma unroll
    for (int j = 0; j < 4; ++j) { A[j] = f32x4{}; B[j] = f32x4{}; C[j] = f32x4{}; }
    for (int t = r0; t < r1; ++t) {
        const int bb = tok_bb(t);
        if (bb != cur_bb) { cur_bb = bb;
#pragma unroll
            for (int j = 0; j < 4; ++j) { const int col = 4 * lane + 256 * j;
                if (HAS_H) A[j] = *(const f32x4*)(P.gpost + col) * *(const f32x4*)(P.gate + (size_t)bb * 6144 + col);
                if (HAS_HN) { B[j] = *(const f32x4*)(P.g2 + col) * (*(const f32x4*)(P.scale + (size_t)bb * 6144 + col) + 1.f); C[j] = *(const f32x4*)(P.shift + (size_t)bb * 6144 + col); } } }
        f32x4 xv[4];
        if (XIN_BF) { const bf16_t* xb = (const bf16_t*)(P.xout + (size_t)t * DM);
#pragma unroll
            for (int j = 0; j < 4; ++j) { const u32x2 w = *(const u32x2*)(xb + 4 * lane + 256 * j); xv[j] = (f32x4){bf_lo(w.x), bf_hi(w.x), bf_lo(w.y), bf_hi(w.y)}; }
        } else { const float* xr = t < TP ? P.xin0 + (size_t)t * DM : P.xin1 + (size_t)(t - TP) * DM;
#pragma unroll
            for (int j = 0; j < 4; ++j) xv[j] = __builtin_nontemporal_load((const f32x4*)(xr + 4 * lane + 256 * j)); }
        if (HAS_H) {
            const bf16_t* hr = P.h + (size_t)t * DM; f32x4 hv[4]; float ss = 0.f;
#pragma unroll
            for (int j = 0; j < 4; ++j) { const u32x2 w = *(const u32x2*)(hr + 4 * lane + 256 * j); hv[j] = (f32x4){bf_lo(w.x), bf_hi(w.x), bf_lo(w.y), bf_hi(w.y)};
                ss += (hv[j][0] * hv[j][0] + hv[j][1] * hv[j][1]) + (hv[j][2] * hv[j][2] + hv[j][3] * hv[j][3]); }
            const float rstd = __builtin_amdgcn_rsqf(wave_sum(ss) * (1.f / DM) + RMS_EPS);
            float* xo = P.xout + (size_t)t * DM;
#pragma unroll
            for (int j = 0; j < 4; ++j) { xv[j] = xv[j] + A[j] * (hv[j] * rstd);
                if (XOUT_BF) { u32x2 w; w.x = cvt_pk_bf16(xv[j][0], xv[j][1]); w.y = cvt_pk_bf16(xv[j][2], xv[j][3]); *(u32x2*)((bf16_t*)xo + 4 * lane + 256 * j) = w; }
                else __builtin_nontemporal_store(xv[j], (f32x4*)(xo + 4 * lane + 256 * j)); }
        }
        if (HAS_HN) {
            float ss = 0.f;
#pragma unroll
            for (int j = 0; j < 4; ++j) ss += (xv[j][0] * xv[j][0] + xv[j][1] * xv[j][1]) + (xv[j][2] * xv[j][2] + xv[j][3] * xv[j][3]);
            const float rstd = __builtin_amdgcn_rsqf(wave_sum(ss) * (1.f / DM) + RMS_EPS);
            bf16_t* ho = P.hn + (size_t)t * DM;
#pragma unroll
            for (int j = 0; j < 4; ++j) { const f32x4 v = xv[j] * rstd * B[j] + C[j]; u32x2 w; w.x = cvt_pk_bf16(v[0], v[1]); w.y = cvt_pk_bf16(v[2], v[3]); *(u32x2*)(ho + 4 * lane + 256 * j) = w; }
        }
    }
}
__device__ __forceinline__ void lat_rowpass(const float* lat, const float* qn, const float* kvn, const f32x2* rope, bf16_t* CQ, bf16_t* CKV, bf16_t* KR, int gw, int ngw, int lane) {
    const int rpw = (T + ngw - 1) / ngw; const int r0 = gw * rpw, r1 = min(T, r0 + rpw);
    const f32x4 qg = *(const f32x4*)(qn + 4 * lane); const f32x2 kg = *(const f32x2*)(kvn + 2 * lane);
    for (int t = r0; t < r1; ++t) {
        const float* lr = lat + (size_t)t * NLAT;
        const f32x4 q = *(const f32x4*)(lr + 4 * lane); const f32x2 k = *(const f32x2*)(lr + 256 + 2 * lane);
        float x1 = 0.f, x2 = 0.f; if (lane < 16) { x1 = lr[384 + lane]; x2 = lr[400 + lane]; }
        float sq = (q[0] * q[0] + q[1] * q[1]) + (q[2] * q[2] + q[3] * q[3]), sk = k[0] * k[0] + k[1] * k[1];
#pragma unroll
        for (int o = 1; o < 64; o <<= 1) { sq += __shfl_xor(sq, o); sk += __shfl_xor(sk, o); }
        const float rq = __builtin_amdgcn_rsqf(sq * (1.f / 256.f) + RMS_EPS), rk = __builtin_amdgcn_rsqf(sk * (1.f / 128.f) + RMS_EPS);
        u32x2 wq; wq.x = cvt_pk_bf16(q[0] * rq * qg[0], q[1] * rq * qg[1]); wq.y = cvt_pk_bf16(q[2] * rq * qg[2], q[3] * rq * qg[3]);
        *(u32x2*)(CQ + (size_t)t * 256 + 4 * lane) = wq;
        *(unsigned*)(CKV + (size_t)t * 128 + 2 * lane) = cvt_pk_bf16(k[0] * rk * kg[0], k[1] * rk * kg[1]);
        if (lane < 16) { const f32x2 cs = rope[(size_t)tok_pos(t) * 16 + lane];
            KR[(size_t)t * 32 + lane] = f2bf(x1 * cs.x - x2 * cs.y); KR[(size_t)t * 32 + 16 + lane] = f2bf(x2 * cs.x + x1 * cs.y); }
    }
}

__device__ __forceinline__ void transpose_item(const float* W, int K, int N, bf16_t* WT, int k0, int n0, int drow0, LAS float* scr, int lane) {
#pragma unroll 8
    for (int i = 0; i < 32; ++i) { const int kk = 2 * i + (lane >> 5); scr[kk * 33 + (lane & 31)] = W[(size_t)(k0 + kk) * N + n0 + (lane & 31)]; }
    asm volatile("s_waitcnt lgkmcnt(0)" ::: "memory");
    const int c = lane & 7;
#pragma unroll
    for (int j = 0; j < 4; ++j) { const int n = (lane >> 3) + 8 * j; const LAS float* s = scr + (8 * c) * 33 + n;
        u32x4 o; o.x = cvt_pk_bf16(s[0 * 33], s[1 * 33]); o.y = cvt_pk_bf16(s[2 * 33], s[3 * 33]); o.z = cvt_pk_bf16(s[4 * 33], s[5 * 33]); o.w = cvt_pk_bf16(s[6 * 33], s[7 * 33]);
        *(u32x4*)(WT + (size_t)(drow0 + n) * K + k0 + 8 * c) = o; }
    asm volatile("s_waitcnt lgkmcnt(0)" ::: "memory");
}

struct Args { const float* in[21]; float* out; unsigned char* ws; int ph_lo, ph_hi; };
constexpr int N_PHASES = 19;

__global__ void __launch_bounds__(512, 2) fwd_kernel(Args args) {
    extern __shared__ __attribute__((aligned(16))) unsigned char lds[];
    cg::grid_group grid = cg::this_grid();
    if (threadIdx.x < 4) ((LAS unsigned*)((LAS unsigned char*)lds + LDS_ST_OFF))[threadIdx.x] = 0u;
    __syncthreads();
    const XcdBarrier xbar = xcd_barrier_post((unsigned*)(args.ws + WS_BAR), (volatile LAS unsigned*)((LAS unsigned char*)lds + LDS_ST_OFF));
    const int ph_lo = args.ph_lo, ph_hi = args.ph_hi;
    int rep_done = 0;
    for (int ph = ph_lo; ph < ph_hi; ++ph) {
        const unsigned char __attribute__((address_space(4)))* kp = (const unsigned char __attribute__((address_space(4)))*)__builtin_amdgcn_kernarg_segment_ptr();
        asm volatile("" : "+s"(kp));
        int tid = threadIdx.x, bid = blockIdx.x, G = gridDim.x;
        asm volatile("" : "+v"(tid)); asm volatile("" : "+s"(bid)); asm volatile("" : "+s"(G));
        const int lane = tid & 63, wid = __builtin_amdgcn_readfirstlane(tid >> 6);
        const int gw = bid * 8 + wid, ngw = G * 8;
#define AIN(i) (*(const float* const __attribute__((address_space(4)))*)(kp + 8 * (i)))
        float* out = *(float* const __attribute__((address_space(4)))*)(kp + 8 * 21);
        unsigned char* ws = *(unsigned char* const __attribute__((address_space(4)))*)(kp + 8 * 22);
        bf16_t* Wdkv_t = (bf16_t*)(ws + WS_WDKV); bf16_t* Wuq_t = (bf16_t*)(ws + WS_WUQ); bf16_t* Wukv_t = (bf16_t*)(ws + WS_WUKV); bf16_t* Wo_t = (bf16_t*)(ws + WS_WO);
        bf16_t* NAqkv_t = (bf16_t*)(ws + WS_NAQKV); bf16_t* NAo_t = (bf16_t*)(ws + WS_NAO); bf16_t* Wgu_t = (bf16_t*)(ws + WS_WGU); bf16_t* Wdn_t = (bf16_t*)(ws + WS_WDN);
        float* MOD = (float*)(ws + WS_MOD); f32x2* ROPE = (f32x2*)(ws + WS_ROPE);
        bf16_t* HN = (bf16_t*)(ws + WS_HN); bf16_t* OB = HN;
        float* LAT = (float*)(ws + WS_R1); bf16_t* KV = (bf16_t*)(ws + WS_R1); bf16_t* HMIX = (bf16_t*)(ws + WS_R1); bf16_t* QKV = (bf16_t*)(ws + WS_R1);
        bf16_t* HID = (bf16_t*)(ws + WS_HID); bf16_t* QB = (bf16_t*)(ws + WS_Q); bf16_t* KR = (bf16_t*)(ws + WS_KR); bf16_t* CQ = (bf16_t*)(ws + WS_CQ); bf16_t* CKV = (bf16_t*)(ws + WS_CKV);
        const float* x_p = AIN(0); const float* x_s = AIN(1);


        int kind = ph, l = 0; if (ph >= 14) { kind = ph - 7; l = 1; }
        switch (kind) {
        case 0: if (PH_ON(0)) {
            if (bid < 192) {
                float* cact = (float*)lds;
                float* part = (float*)(lds + 65536);
                for (int i = tid; i < 16384; i += 512) { const int bb = i >> 10, k = i & 1023; const float c = bb < 8 ? AIN(2)[bb * 1024 + k] : AIN(3)[(bb - 8) * 1024 + k];
                    cact[k * 16 + bb] = c / (1.f + expf(-c)); }
                __syncthreads();
                const int item = bid, ml = item / 96, n0 = (item % 96) * 64;
                const float* wp = AIN(4) + ((size_t)ml * 1024 + 128 * wid) * 6144 + n0 + lane;
                float acc[16];
#pragma unroll
                for (int i = 0; i < 16; ++i) acc[i] = 0.f;
#pragma unroll 8
                for (int kk = 0; kk < 128; ++kk) { const float w = wp[(size_t)kk * 6144]; const f32x4* cv = (const f32x4*)(cact + (128 * wid + kk) * 16);
#pragma unroll
                    for (int q = 0; q < 4; ++q) { const f32x4 c4 = cv[q]; acc[4 * q] += c4[0] * w; acc[4 * q + 1] += c4[1] * w; acc[4 * q + 2] += c4[2] * w; acc[4 * q + 3] += c4[3] * w; } }
#pragma unroll
                for (int i = 0; i < 16; ++i) part[(wid * 16 + i) * 64 + lane] = acc[i];
                __syncthreads();
                for (int o = tid; o < 1024; o += 512) { const int bb = o >> 6, ln = o & 63; float s = 0.f;
#pragma unroll
                    for (int w = 0; w < 8; ++w) s += part[(w * 16 + bb) * 64 + ln];
                    MOD[((size_t)ml * 16 + bb) * 6144 + n0 + ln] = s + AIN(5)[ml * 6144 + n0 + ln]; }
                __syncthreads();
            }
            for (int idx = bid * 512 + tid; idx < 8192 * 16; idx += G * 512) { const int s = idx >> 4, f = idx & 15;
                const float invf = exp2f(-(float)f * 0.8304820237218405f); const float ang = (float)s * invf;
                double rev = (double)ang * 0.15915494309189535; rev -= floor(rev); const float fr = (float)rev;
                ROPE[idx] = (f32x2){__builtin_amdgcn_cosf(fr), __builtin_amdgcn_sinf(fr)}; }
            { unsigned z_ = 0u; asm volatile("" : "+v"(z_));
              for (int i = bid * 512 + tid; i < 96 * 1024 / 8; i += G * 512) *(u32x4*)(Wdkv_t + (size_t)416 * 1024 + (size_t)i * 8) = (u32x4){z_, z_, z_, z_}; }
            {
                LAS float* scr = (LAS float*)((LAS unsigned char*)lds + wid * 16384);
                constexpr int I0 = 16 * 13, I1 = 4 * 48, I2 = 2 * 64, I3 = 16 * 32, I4 = 16 * 96, I5 = 16 * 32, I6 = 16 * 176, I7 = 44 * 32;
                constexpr int NIT = I0 + I1 + I2 + I3 + I4 + I5 + 2 * I6 + 2 * I7;
                for (int it = gw; it < NIT; it += ngw) {
                    int r = it;
                    if (r < I0) { transpose_item(AIN(10), 1024, 416, Wdkv_t, 64 * (r / 13), 32 * (r % 13), 32 * (r % 13), scr, lane); continue; } r -= I0;
                    if (r < I1) { transpose_item(AIN(13), 256, 1536, Wuq_t, 64 * (r / 48), 32 * (r % 48), 32 * (r % 48), scr, lane); continue; } r -= I1;
                    if (r < I2) { transpose_item(AIN(14), 128, 2048, Wukv_t, 64 * (r / 64), 32 * (r % 64), 32 * (r % 64), scr, lane); continue; } r -= I2;
                    if (r < I3) { transpose_item(AIN(15), 1024, 1024, Wo_t, 64 * (r / 32), 32 * (r % 32), 32 * (r % 32), scr, lane); continue; } r -= I3;
                    if (r < I4) { transpose_item(AIN(16), 1024, 3072, NAqkv_t, 64 * (r / 96), 32 * (r % 96), 32 * (r % 96), scr, lane); continue; } r -= I4;
                    if (r < I5) { transpose_item(AIN(18), 1024, 1024, NAo_t, 64 * (r / 32), 32 * (r % 32), 32 * (r % 32), scr, lane); continue; } r -= I5;
                    if (r < 2 * I6) { const int ll = r / I6; r -= ll * I6; const int n0 = 32 * (r % 176); const int jj = n0 < FF ? n0 : n0 - FF; const int drow = (jj >> 7) * 256 + (n0 < FF ? 0 : 128) + (jj & 127);
                        transpose_item(AIN(19) + (size_t)ll * 1024 * 5632, 1024, 5632, Wgu_t + (size_t)ll * 5632 * 1024, 64 * (r / 176), n0, drow, scr, lane); continue; } r -= 2 * I6;
                    { const int ll = r / I7; r -= ll * I7; transpose_item(AIN(20) + (size_t)ll * FF * 1024, FF, 1024, Wdn_t + (size_t)ll * 1024 * FF, 64 * (r / 32), 32 * (r % 32), 32 * (r % 32), scr, lane); }
                }
            }
        } break;
        case 1: if (PH_ON(1)) {
            RowP P{x_p, x_s, nullptr, nullptr, nullptr, nullptr, HN, AIN(6), MOD + 1 * 1024, MOD + 0 * 1024};
            rowpass<false, true, false, false>(P, gw, ngw, lane);
        } break;
        case 2: if (PH_ON(2)) {
            pg8::Gemm g{HN, Wdkv_t, T, NLAT, 1024}; pg8::StaticOrder S; S.init(T, NLAT, G, bid);
            pg8::EpiLat E{CQ, CKV, KR, AIN(11), AIN(12), ROPE, (LAS float*)((LAS unsigned char*)lds + 131072)};
            pg8::gemm_phase<pg8::EpiLat>((LAS unsigned char*)lds, g, S, E, tid);
        } break;
        case 3: break;
        case 4: case 5: case 7: case 10: case 12: if (PH_ON(5)) {
            pg8::Gemm g; pg8::EpiBf16S E; E.scale_cols = 0; E.scale0 = 1.f;
            if (kind == 4) { g = pg8::Gemm{CQ, Wuq_t, T, NQ, 256}; E.O = QB; E.ldc = NQ; E.scale_cols = NQ; E.scale0 = QSCALE_MLA; }
            else if (kind == 5) { g = pg8::Gemm{CKV, Wukv_t, T, NKV, 128}; E.O = KV; E.ldc = NKV; }
            else if (kind == 7) { g = pg8::Gemm{OB, l ? NAo_t : Wo_t, T, 1024, 1024}; E.O = HMIX; E.ldc = 1024; }
            else if (kind == 10) { g = pg8::Gemm{HID, Wdn_t + (size_t)l * 1024 * FF, T, 1024, FF}; E.O = HMIX; E.ldc = 1024; }
            else { g = pg8::Gemm{HN, NAqkv_t, T, 3072, 1024}; E.O = QKV; E.ldc = 3072; E.scale_cols = 1024; E.scale0 = QSCALE_NA; }
            pg8::StaticOrder S; S.init(T, g.N, G, bid);
            pg8::gemm_phase<pg8::EpiBf16S>((LAS unsigned char*)lds, g, S, E, tid);
        } break;
        case 6: if (PH_ON(6)) {
            mla::phase(QB, KV, KR, OB, ROPE, (char*)lds, tid, bid, G);
        } break;
        case 8: if (PH_ON(8)) {
            const float* md = MOD + (size_t)l * 16 * 6144;
            RowP P{l ? out : x_p, l ? out + (size_t)TP * DM : x_s, HMIX, AIN(7) + l * 1024, md + 2 * 1024, out, HN, AIN(8) + l * 1024, md + 4 * 1024, md + 3 * 1024};
            if (l == 0) rowpass<true, true, false, true>(P, gw, ngw, lane); else rowpass<true, true, true, true>(P, gw, ngw, lane);
        } break;
        case 9: if (PH_ON(9)) {
            pg8::Gemm g{HN, Wgu_t + (size_t)l * 5632 * 1024, T, 5632, 1024}; pg8::StaticOrder S; S.init(T, 5632, G, bid);
            pg8::EpiSwiGLU E{HID};
            pg8::gemm_phase<pg8::EpiSwiGLU>((LAS unsigned char*)lds, g, S, E, tid);
        } break;
        case 11: if (PH_ON(11)) {
            const float* md = MOD + (size_t)l * 16 * 6144; const float* md1 = MOD + (size_t)16 * 6144;
            RowP P{out, out + (size_t)TP * DM, HMIX, AIN(9) + l * 1024, md + 5 * 1024, out, HN, AIN(6) + 1024, md1 + 1 * 1024, md1 + 0 * 1024};
            if (l == 0) rowpass<true, true, true, true>(P, gw, ngw, lane); else rowpass<true, false, true, false>(P, gw, ngw, lane);
        } break;
        case 13: if (PH_ON(13)) {
            na::phase(QKV, OB, AIN(17), (char*)lds, tid, bid, G);
        } break;
        default: break;
        }
#if MK_MULTI
#define SEAM() do { } while (0)
#else
#define SEAM() do { if (ph_lo < 0) grid.sync(); XcdBarrier xb_ = xbar; asm volatile("" : "+s"(xb_.bar)); xcd_barrier(xb_); } while (0)
#endif
        if (REP_MASK != 0 && ((REP_MASK >> ph) & 1) && !rep_done) { rep_done = 1; --ph; SEAM(); continue; }
        rep_done = 0;
        if (ph + 1 < ph_hi && ph != 4 && ph != 3) { SEAM(); for (int e = 0; e < EXTRA_SYNC; ++e) SEAM(); }
    }
}

extern "C" void kernel_launch(void* const* d_in, const int* in_sizes, int n_in, void* d_out, int out_size, void* d_ws, size_t ws_size, hipStream_t stream) {
    static int grid = 0;
    if (grid == 0) {
        if (n_in != 21 || out_size != T * DM || ws_size < WS_END) { fprintf(stderr, "kernel_launch: unexpected shapes: n_in %d out %d ws %zu\n", n_in, out_size, ws_size); grid = -1; return; }
        int dev = 0, cus = 0, per_cu = 0;
        hipGetDevice(&dev); hipDeviceGetAttribute(&cus, hipDeviceAttributeMultiprocessorCount, dev);
        if (hipFuncSetAttribute((const void*)fwd_kernel, hipFuncAttributeMaxDynamicSharedMemorySize, LDS_BYTES) != hipSuccess) { fprintf(stderr, "kernel_launch: hipFuncSetAttribute failed\n"); grid = -1; return; }
        hipOccupancyMaxActiveBlocksPerMultiprocessor(&per_cu, (const void*)fwd_kernel, 512, LDS_BYTES);
        per_cu = 1;
        grid = cus * per_cu;
        fprintf(stderr, "kernel_launch: cus %d per_cu %d grid %d\n", cus, per_cu, grid);
    }
    if (grid < 0) return;
    Args a{};
    for (int i = 0; i < 21; ++i) a.in[i] = (const float*)d_in[i];
    a.out = (float*)d_out; a.ws = (unsigned char*)d_ws;
#if MK_MULTI
    for (int ph = 0; ph < N_PHASES; ++ph) {
        a.ph_lo = ph; a.ph_hi = ph + 1;
        hipLaunchKernelGGL(fwd_kernel, dim3(grid), dim3(512), LDS_BYTES, stream, a);
    }
#else
    a.ph_lo = 0; a.ph_hi = N_PHASES;
    if (hipMemsetAsync((char*)d_ws + WS_BAR, 0, BAR_BYTES, stream) != hipSuccess) { fprintf(stderr, "kernel_launch: memset failed\n"); return; }
    void* kargs[] = {&a};
    hipError_t e = hipLaunchCooperativeKernel((const void*)fwd_kernel, dim3(grid), dim3(512), kargs, LDS_BYTES, stream);
    if (e != hipSuccess) fprintf(stderr, "kernel_launch: cooperative launch failed: %s (grid %d)\n", hipGetErrorString(e), grid);
#endif
}
```

```cpp
#include <hip/hip_runtime.h>
#include <hip/hip_cooperative_groups.h>
#include <cstdio>
#include <cstdint>
namespace cg = cooperative_groups;

#ifndef PH_MASK
#define PH_MASK 0xFFFFF
#endif
#define PH_ON(k) ((PH_MASK >> (k)) & 1)
#ifndef REP_MASK
#define REP_MASK 0
#endif
#ifndef EXTRA_SYNC
#define EXTRA_SYNC 0
#endif
#ifndef MK_MULTI
#define MK_MULTI 0
#endif

#define LAS __attribute__((address_space(3)))
typedef unsigned short bf16_t;
typedef short bf16x8 __attribute__((ext_vector_type(8)));
typedef short s16x4 __attribute__((ext_vector_type(4)));
typedef float f32x2 __attribute__((ext_vector_type(2)));
typedef float f32x4 __attribute__((ext_vector_type(4)));
typedef float f32x16 __attribute__((ext_vector_type(16)));
typedef unsigned u32x2 __attribute__((ext_vector_type(2)));
typedef unsigned u32x4 __attribute__((ext_vector_type(4)));

constexpr int DM = 1024, TP = 65536, T = 98304, FF = 2816;
constexpr int NQ = 1536, NKV = 2048, NLAT = 512;
constexpr float RMS_EPS = 1e-6f;
constexpr float LOG2E = 1.4426950408889634f;
constexpr float QSCALE_MLA = 0.10206207261596577f * LOG2E;
constexpr float QSCALE_NA = 0.125f * LOG2E;

constexpr size_t MiB = 1u << 20;
constexpr size_t WS_WDKV = 0, WS_WUQ = 1 * MiB, WS_WUKV = 2 * MiB, WS_WO = 3 * MiB, WS_NAQKV = 5 * MiB, WS_NAO = 11 * MiB,
                 WS_WGU = 13 * MiB  , WS_WDN = 35 * MiB  , WS_MOD = 46 * MiB, WS_ROPE = 47 * MiB;
constexpr size_t WS_BAR = 48 * MiB, BAR_BYTES = 16384;
constexpr size_t WS_HN = 64 * MiB;
constexpr size_t WS_R1 = 256 * MiB;
constexpr size_t WS_HID = 448 * MiB;
constexpr size_t WS_Q = 640 * MiB;
constexpr size_t WS_KR = 928 * MiB;
constexpr size_t WS_CQ = 934 * MiB;
constexpr size_t WS_CKV = 982 * MiB;
constexpr size_t WS_END = 1006 * MiB;
constexpr int LDS_ST_OFF = 163840 - 64;
constexpr int LDS_BYTES = 163840;

__device__ __forceinline__ unsigned cvt_pk_bf16(float lo, float hi) { unsigned r; asm("v_cvt_pk_bf16_f32 %0, %1, %2" : "=v"(r) : "v"(lo), "v"(hi)); return r; }
__device__ __forceinline__ bf16_t f2bf(float x) { return (bf16_t)(cvt_pk_bf16(x, x) & 0xffffu); }
__device__ __forceinline__ float bf_lo(unsigned u) { return __uint_as_float(u << 16); }
__device__ __forceinline__ float bf_hi(unsigned u) { return __uint_as_float(u & 0xffff0000u); }
__device__ __forceinline__ float wave_sum(float v) {
#pragma unroll
    for (int o = 1; o < 64; o <<= 1) v += __shfl_xor(v, o);
    return v;
}
__device__ __forceinline__ int tok_pos(int t) { return t < TP ? (t & 8191) : (t & 4095); }
__device__ __forceinline__ int tok_bb(int t) { return t < TP ? (t >> 13) : 8 + ((t - TP) >> 12); }

namespace pg8 {
constexpr int BM = 256, BK = 64, HALF = 128, HTB = HALF * BK * 2, NXCD = 8, WGM = 8;
__host__ __device__ __forceinline__ int lds_byte(int r, int c) { const int st = (r >> 4) * 2 + (c >> 5), rr = r & 15, cc = c & 31, ob = rr * 64 + cc * 2; return st * 1024 + (ob ^ (((ob >> 9) & 1) << 5)); }
__host__ __device__ __forceinline__ void stage_rc(int b, int& R, int& C) { const int st = b / 1024, sb = b % 1024, swz = sb ^ (((sb >> 9) & 1) << 5); R = (st >> 1) * 16 + swz / 64; C = (st & 1) * 32 + (swz % 64) / 2; }
__host__ __device__ __forceinline__ int perm32(int rho) { const int n = rho >> 4, i = rho & 15; return 8 * (i >> 2) + 4 * n + (i & 3); }

struct Unit { int pm, pn; };
struct Gemm { const bf16_t* A; const bf16_t* Bt; int M, N, K; };

struct StaticOrder {
    int nM, nN, nwg, G, c;
    __device__ void init(int M, int N, int G_, int c_) { nM = M / BM; nN = N / BM; nwg = nM * nN; G = G_; c = c_; }
    __device__ bool next(int i, Unit& u) const {
        const long L = (long)i * G + c; if (L >= nwg) return false;
        int wgid = (int)L; { const int q = nwg / NXCD, r = nwg % NXCD, xcd = wgid % NXCD, off = wgid / NXCD; wgid = (xcd < r ? xcd * (q + 1) : r * (q + 1) + (xcd - r) * q) + off; }
        const int nig = WGM * nN, gid = wgid / nig, fm = gid * WGM, gsz = (nM - fm) < WGM ? (nM - fm) : WGM;
        u.pm = fm + ((wgid % nig) % gsz); u.pn = (wgid % nig) / gsz; return true;
    }
};


struct EpiF32 {
    static constexpr bool PERM = false;
    float* O; int ldc;
    __device__ __forceinline__ void operator()(const f32x4 (&acc)[2][2][4][2], const Unit& u, int wr, int wc, int fr, int fq) const {
        const int row0 = u.pm * BM + wr * 64 + fr, col0 = u.pn * BM + wc * 32 + 4 * fq;
#pragma unroll
        for (int ai = 0; ai < 2; ++ai)
#pragma unroll
            for (int m = 0; m < 4; ++m) { float* rowp = O + (size_t)(row0 + ai * HALF + m * 16) * ldc + col0;
#pragma unroll
                for (int bj = 0; bj < 2; ++bj)
#pragma unroll
                    for (int n = 0; n < 2; ++n) *(f32x4*)(rowp + bj * HALF + n * 16) = acc[ai][bj][m][n]; }
    }
};
struct EpiLat {
    static constexpr bool PERM = false;
    bf16_t* CQ; bf16_t* CKV; bf16_t* KR; const float* qn; const float* kvn; const f32x2* rope; LAS float* xch;
    __device__ __forceinline__ void operator()(const f32x4 (&acc)[2][2][4][2], const Unit& u, int wr, int wc, int fr, int fq) const {
        const bool is_q = (u.pn == 0);
        LAS float* xw = xch + ((wr * 64 + fr) * 16 + wc * 4 + fq); const LAS float* xr = xch + (wr * 64 + fr) * 16;
#pragma unroll
        for (int ai = 0; ai < 2; ++ai)
#pragma unroll
            for (int m = 0; m < 4; ++m) { float sq = 0.f;
#pragma unroll
                for (int n = 0; n < 2; ++n) { const f32x4 x = acc[ai][0][m][n]; sq += (x[0] * x[0] + x[1] * x[1]) + (x[2] * x[2] + x[3] * x[3]); }
                if (is_q) {
#pragma unroll
                    for (int n = 0; n < 2; ++n) { const f32x4 x = acc[ai][1][m][n]; sq += (x[0] * x[0] + x[1] * x[1]) + (x[2] * x[2] + x[3] * x[3]); } }
                xw[(ai * HALF + m * 16) * 16] = sq; }
        asm volatile("s_waitcnt lgkmcnt(0)\n\ts_barrier" ::: "memory");
        const int col0 = wc * 32 + 4 * fq;
        if (is_q) {
#pragma unroll
            for (int ai = 0; ai < 2; ++ai)
#pragma unroll
                for (int m = 0; m < 4; ++m) { const int rl = ai * HALF + wr * 64 + m * 16 + fr; bf16_t* op = CQ + ((size_t)u.pm * BM + rl) * 256 + col0;
                    float tot = 0.f;
#pragma unroll
                    for (int q4 = 0; q4 < 4; ++q4) { const f32x4 pr = *(const LAS f32x4*)(xr + (ai * HALF + m * 16) * 16 + q4 * 4); tot += (pr[0] + pr[1]) + (pr[2] + pr[3]); }
                    const float rstd = __builtin_amdgcn_rsqf(tot * (1.f / 256.f) + RMS_EPS);
#pragma unroll
                    for (int bj = 0; bj < 2; ++bj)
#pragma unroll
                        for (int n = 0; n < 2; ++n) { const f32x4 g = *(const f32x4*)(qn + bj * HALF + col0 + n * 16); const f32x4 v = acc[ai][bj][m][n] * rstd * g;
                            u32x2 w; w.x = cvt_pk_bf16(v[0], v[1]); w.y = cvt_pk_bf16(v[2], v[3]); *(u32x2*)(op + bj * HALF + n * 16) = w; }
                    asm volatile("" ::: "memory"); }
        } else {
#pragma unroll
            for (int ai = 0; ai < 2; ++ai)
#pragma unroll
                for (int m = 0; m < 4; ++m) { const int rl = ai * HALF + wr * 64 + m * 16 + fr; const size_t row = (size_t)u.pm * BM + rl;
                    float tot = 0.f;
#pragma unroll
                    for (int q4 = 0; q4 < 4; ++q4) { const f32x4 pr = *(const LAS f32x4*)(xr + (ai * HALF + m * 16) * 16 + q4 * 4); tot += (pr[0] + pr[1]) + (pr[2] + pr[3]); }
                    const float rstd = __builtin_amdgcn_rsqf(tot * (1.f / 128.f) + RMS_EPS);
#pragma unroll
                    for (int n = 0; n < 2; ++n) { const f32x4 g = *(const f32x4*)(kvn + col0 + n * 16); const f32x4 v = acc[ai][0][m][n] * rstd * g;
                        u32x2 w; w.x = cvt_pk_bf16(v[0], v[1]); w.y = cvt_pk_bf16(v[2], v[3]); *(u32x2*)(CKV + row * 128 + col0 + n * 16) = w; }
                    if (wc == 0) { const f32x4* rp = (const f32x4*)(rope + (size_t)tok_pos((int)row) * 16 + 4 * fq); const f32x4 cs0 = rp[0], cs1 = rp[1];
                        const f32x4 c = {cs0[0], cs0[2], cs1[0], cs1[2]}, sn = {cs0[1], cs0[3], cs1[1], cs1[3]};
                        const f32x4 x1 = acc[ai][1][m][0], x2 = acc[ai][1][m][1]; const f32x4 o1 = x1 * c - x2 * sn, o2 = x2 * c + x1 * sn;
                        u32x2 w1, w2; w1.x = cvt_pk_bf16(o1[0], o1[1]); w1.y = cvt_pk_bf16(o1[2], o1[3]); w2.x = cvt_pk_bf16(o2[0], o2[1]); w2.y = cvt_pk_bf16(o2[2], o2[3]);
                        *(u32x2*)(KR + row * 32 + 4 * fq) = w1; *(u32x2*)(KR + row * 32 + 16 + 4 * fq) = w2; }
                    asm volatile("" ::: "memory"); }
        }
        asm volatile("s_waitcnt lgkmcnt(0)\n\ts_barrier" ::: "memory");
    }
};
struct EpiBf16S {
    static constexpr bool PERM = true;
    bf16_t* O; int ldc; int scale_cols; float scale0;
    __device__ __forceinline__ void operator()(const f32x4 (&acc)[2][2][4][2], const Unit& u, int wr, int wc, int fr, int fq) const {
        const int row0 = u.pm * BM + wr * 64 + fr, col0 = u.pn * BM + wc * 32 + 8 * fq;
        const float sc = (u.pn * BM < scale_cols) ? scale0 : 1.f;
#pragma unroll
        for (int ai = 0; ai < 2; ++ai)
#pragma unroll
            for (int m = 0; m < 4; ++m) { bf16_t* rowp = O + (size_t)(row0 + ai * HALF + m * 16) * ldc + col0;
#pragma unroll
                for (int bj = 0; bj < 2; ++bj) { const f32x4 v0 = acc[ai][bj][m][0] * sc, v1 = acc[ai][bj][m][1] * sc;
                    u32x4 w; w.x = cvt_pk_bf16(v0[0], v0[1]); w.y = cvt_pk_bf16(v0[2], v0[3]); w.z = cvt_pk_bf16(v1[0], v1[1]); w.w = cvt_pk_bf16(v1[2], v1[3]);
                    *(u32x4*)(rowp + bj * HALF) = w; } }
    }
};
struct EpiSwiGLU {
    static constexpr bool PERM = true;
    bf16_t* O;
    __device__ __forceinline__ void operator()(const f32x4 (&acc)[2][2][4][2], const Unit& u, int wr, int wc, int fr, int fq) const {
        const int row0 = u.pm * BM + wr * 64 + fr, col0 = u.pn * HALF + wc * 32 + 8 * fq;
#pragma unroll
        for (int ai = 0; ai < 2; ++ai)
#pragma unroll
            for (int m = 0; m < 4; ++m) { bf16_t* rowp = O + (size_t)(row0 + ai * HALF + m * 16) * FF + col0;
                float v[8];
#pragma unroll
                for (int n = 0; n < 2; ++n)
#pragma unroll
                    for (int i = 0; i < 4; ++i) { const float g = acc[ai][0][m][n][i], up = acc[ai][1][m][n][i];
                        v[n * 4 + i] = g * __builtin_amdgcn_rcpf(1.f + __builtin_amdgcn_exp2f(-g * LOG2E)) * up; }
                u32x4 w; w.x = cvt_pk_bf16(v[0], v[1]); w.y = cvt_pk_bf16(v[2], v[3]); w.z = cvt_pk_bf16(v[4], v[5]); w.w = cvt_pk_bf16(v[6], v[7]);
                *(u32x4*)rowp = w; }
    }
};

template <class Epi>
__device__ __forceinline__ void gemm_phase(LAS unsigned char* lds, const Gemm g, const StaticOrder& S, const Epi& E, const int tid) {
    const int wid = __builtin_amdgcn_readfirstlane(tid >> 6), lane = tid & 63, wr = wid >> 2, wc = wid & 3, fr = lane & 15, fq = lane >> 4;
    const int K = g.K, nt = K / BK;
    unsigned voffA[2], voffB[2];
#pragma unroll
    for (int i = 0; i < 2; ++i) { int R, C; stage_rc(tid * 16 + i * 8192, R, C); const int Rb = Epi::PERM ? ((R & ~31) + perm32(R & 31)) : R;
        voffA[i] = (unsigned)(R * K + C) * 2u; voffB[i] = (unsigned)(Rb * K + C) * 2u; }
    const size_t kstep = (size_t)(BK * 2);
    const size_t hstep = (size_t)HALF * K * 2;
    const size_t tstep = 2 * hstep;
    const unsigned ldsw = (unsigned)wid * 1024u;
    const int aoff = lds_byte(wr * 64 + fr, fq * 8), boff = lds_byte(wc * 32 + fr, fq * 8);
#define PG8_SA(b, h) (((b) * 2 + (h)) * HTB)
#define PG8_SB(b, h) ((4 + (b) * 2 + (h)) * HTB)
#define PG8_STAGE(bufoff, gbase, voff) do { _Pragma("unroll") for (int _i = 0; _i < 2; ++_i) \
        __builtin_amdgcn_global_load_lds((const unsigned*)((const char*)(gbase) + (voff)[_i]), (LAS unsigned*)(lds + (bufoff) + ldsw + _i * 8192), 16, 0, 0); } while (0)
#define PG8_LDA(dst, b, h) do { _Pragma("unroll") for (int m = 0; m < 4; ++m) _Pragma("unroll") for (int k = 0; k < 2; ++k) dst[m][k] = *(const LAS bf16x8*)(lds + PG8_SA(b, h) + aoff + m * 2048 + k * 1024); } while (0)
#define PG8_LDB(dst, b, h) do { _Pragma("unroll") for (int n = 0; n < 2; ++n) _Pragma("unroll") for (int k = 0; k < 2; ++k) dst[n][k] = *(const LAS bf16x8*)(lds + PG8_SB(b, h) + boff + n * 2048 + k * 1024); } while (0)
#define PG8_MMA(ai, bj, At, Bt) do { __builtin_amdgcn_s_setprio(1); _Pragma("unroll") for (int m = 0; m < 4; ++m) _Pragma("unroll") for (int n = 0; n < 2; ++n) _Pragma("unroll") for (int k = 0; k < 2; ++k) \
        acc[ai][bj][m][n] = __builtin_amdgcn_mfma_f32_16x16x32_bf16(Bt[n][k], At[m][k], acc[ai][bj][m][n], 0, 0, 0); __builtin_amdgcn_s_setprio(0); } while (0)
#define PG8_WAIT_V(n) asm volatile("s_waitcnt vmcnt(" #n ")" ::: "memory")
#define PG8_WAIT_L(n) asm volatile("s_waitcnt lgkmcnt(" #n ")" ::: "memory")
#define PG8_BAR __builtin_amdgcn_s_barrier()
#define PG8_SCHED __builtin_amdgcn_sched_barrier(0)
    Unit cur, nxt; int ui = 0;
    if (!S.next(0, cur)) return;
    f32x4 acc[2][2][4][2];
#pragma unroll
    for (int a = 0; a < 2; ++a)
#pragma unroll
        for (int b = 0; b < 2; ++b)
#pragma unroll
            for (int m = 0; m < 4; ++m)
#pragma unroll
                for (int n = 0; n < 2; ++n) acc[a][b][m][n] = (f32x4){0.f, 0.f, 0.f, 0.f};
    bf16x8 At[4][2], B0[2][2], B1[2][2];
    const char* cA = (const char*)g.A + (size_t)cur.pm * tstep; const char* cB = (const char*)g.Bt + (size_t)cur.pn * tstep;
    PG8_STAGE(PG8_SB(0, 0), cB, voffB); PG8_STAGE(PG8_SB(0, 1), cB + hstep, voffB); PG8_STAGE(PG8_SA(0, 0), cA, voffA); PG8_STAGE(PG8_SA(0, 1), cA + hstep, voffA);
    if (wr == 1) PG8_BAR;
    PG8_WAIT_V(2); PG8_BAR;
    PG8_STAGE(PG8_SB(1, 0), cB + kstep, voffB); PG8_STAGE(PG8_SA(1, 0), cA + kstep, voffA); PG8_STAGE(PG8_SB(1, 1), cB + hstep + kstep, voffB);
    PG8_WAIT_V(6); PG8_BAR;
    for (;;) {
        const bool has_next = S.next(ui + 1, nxt);
        const char* nA = has_next ? (const char*)g.A + (size_t)nxt.pm * tstep : cA; const char* nB = has_next ? (const char*)g.Bt + (size_t)nxt.pn * tstep : cB;
        for (int t = 0; t < nt; t += 2) {
            const bool last = (t == nt - 2);
            const char* a1 = cA + (size_t)(t + 1) * kstep;
            const char* a2 = last ? nA : cA + (size_t)(t + 2) * kstep; const char* b2 = last ? nB : cB + (size_t)(t + 2) * kstep;
            const char* a3 = a2 + kstep; const char* b3 = b2 + kstep;
            PG8_LDB(B0, 0, 0); PG8_LDB(B1, 0, 1); PG8_SCHED; PG8_LDA(At, 0, 0); PG8_STAGE(PG8_SA(1, 1), a1 + hstep, voffA);
            PG8_WAIT_V(8); PG8_WAIT_L(0); PG8_BAR; PG8_MMA(0, 0, At, B0); PG8_MMA(0, 1, At, B1); PG8_BAR; PG8_SCHED;
            PG8_LDA(At, 0, 1); PG8_STAGE(PG8_SB(0, 0), b2, voffB); PG8_STAGE(PG8_SB(0, 1), b2 + hstep, voffB); PG8_STAGE(PG8_SA(0, 0), a2, voffA);
            PG8_WAIT_V(8); PG8_WAIT_L(0); PG8_BAR; PG8_MMA(1, 0, At, B0); PG8_MMA(1, 1, At, B1); PG8_BAR; PG8_SCHED;
            PG8_LDB(B0, 1, 0); PG8_LDB(B1, 1, 1); PG8_SCHED; PG8_LDA(At, 1, 0); PG8_STAGE(PG8_SA(0, 1), a2 + hstep, voffA);
            PG8_WAIT_V(8); PG8_WAIT_L(0); PG8_BAR; PG8_MMA(0, 0, At, B0); PG8_MMA(0, 1, At, B1); PG8_BAR; PG8_SCHED;
            PG8_LDA(At, 1, 1); PG8_STAGE(PG8_SB(1, 0), b3, voffB); PG8_STAGE(PG8_SB(1, 1), b3 + hstep, voffB); PG8_STAGE(PG8_SA(1, 0), a3, voffA);
            PG8_WAIT_V(8); PG8_WAIT_L(0); PG8_BAR; PG8_MMA(1, 0, At, B0); PG8_MMA(1, 1, At, B1); PG8_BAR; PG8_SCHED;
        }
        if (wr == 0) PG8_BAR;
        E(acc, cur, wr, wc, fr, fq);
        if (!has_next) break;
#pragma unroll
        for (int a = 0; a < 2; ++a)
#pragma unroll
            for (int b = 0; b < 2; ++b)
#pragma unroll
                for (int m = 0; m < 4; ++m)
#pragma unroll
                    for (int n = 0; n < 2; ++n) acc[a][b][m][n] = (f32x4){0.f, 0.f, 0.f, 0.f};
        cur = nxt; cA = nA; cB = nB; ++ui;
        if (wr == 1) PG8_BAR;
    }
    PG8_WAIT_V(0);
    PG8_BAR;
#undef PG8_SA
#undef PG8_SB
#undef PG8_STAGE
#undef PG8_LDA
#undef PG8_LDB
#undef PG8_MMA
#undef PG8_WAIT_V
#undef PG8_WAIT_L
#undef PG8_BAR
#undef PG8_SCHED
}
}

#define SBAR() __builtin_amdgcn_sched_barrier(0)
#define KSWZ(row, colB) ((row) * 256 + ((colB) ^ (((row) & 7) << 4)))
__device__ __forceinline__ int crow(int r, int hi) { return (r & 3) + 8 * (r >> 2) + 4 * hi; }
constexpr float SM_THR = 8.f;

__device__ __forceinline__ void partialSM(f32x16& p0, f32x16& p1, float& m_reg, float& mn, float& alpha) {
    float pmax = p0[0];
#pragma unroll
    for (int r = 1; r < 16; ++r) pmax = fmaxf(pmax, p0[r]);
#pragma unroll
    for (int r = 0; r < 16; ++r) pmax = fmaxf(pmax, p1[r]);
    { auto rr = __builtin_amdgcn_permlane32_swap(__float_as_uint(pmax), __float_as_uint(pmax), false, false);
      pmax = fmaxf(__uint_as_float(rr[0]), __uint_as_float(rr[1])); }
    if (__builtin_expect(__all(pmax - m_reg <= SM_THR), 1)) { mn = m_reg; alpha = 1.f; }
    else { mn = fmaxf(m_reg, pmax); alpha = __builtin_amdgcn_exp2f(m_reg - mn); m_reg = mn; }
#pragma unroll
    for (int r = 0; r < 16; ++r) p0[r] -= mn;
#pragma unroll
    for (int r = 0; r < 16; ++r) p1[r] -= mn;
#pragma unroll
    for (int r = 0; r < 16; ++r) p0[r] = __builtin_amdgcn_exp2f(p0[r]);
}
__device__ __forceinline__ void finishSM(f32x16& p0, f32x16& p1, float alpha, float& l_reg, bf16x8& pa0, bf16x8& pa1, bf16x8& pa2, bf16x8& pa3) {
#pragma unroll
    for (int r = 0; r < 16; ++r) p1[r] = __builtin_amdgcn_exp2f(p1[r]);
    float ps = 0;
#pragma unroll
    for (int r = 0; r < 16; ++r) ps += p0[r];
#pragma unroll
    for (int r = 0; r < 16; ++r) ps += p1[r];
    { auto rr = __builtin_amdgcn_permlane32_swap(__float_as_uint(ps), __float_as_uint(ps), false, false);
      ps = __uint_as_float(rr[0]) + __uint_as_float(rr[1]); }
    l_reg = l_reg * alpha + ps;
#define PK4(P, BASE, OUT) do { unsigned a0 = cvt_pk_bf16(P[BASE + 0], P[BASE + 1]), a1 = cvt_pk_bf16(P[BASE + 2], P[BASE + 3]);   \
    unsigned b0 = cvt_pk_bf16(P[BASE + 4], P[BASE + 5]), b1 = cvt_pk_bf16(P[BASE + 6], P[BASE + 7]);                              \
    auto r0 = __builtin_amdgcn_permlane32_swap(a0, b0, false, false); auto r1 = __builtin_amdgcn_permlane32_swap(a1, b1, false, false); \
    u32x4 w = {r0[0], r1[0], r0[1], r1[1]}; OUT = *reinterpret_cast<bf16x8*>(&w); } while (0)
    PK4(p0, 0, pa0); PK4(p0, 8, pa1); PK4(p1, 0, pa2); PK4(p1, 8, pa3);
#undef PK4
}
__device__ __forceinline__ int v_st(int k, int c) { const int kk = (k & ~0xC) | ((k & 4) << 1) | ((k & 8) >> 1); return ((kk >> 3) * 2 + (c >> 5)) * 512 + ((kk & 7) * 32 + (c & 31)) * 2; }
__device__ __forceinline__ int v_st_nat(int k, int c) { return ((k >> 3) * 2 + (c >> 5)) * 512 + ((k & 7) * 32 + (c & 31)) * 2; }
__device__ __forceinline__ int v_rd_base(int lane) { return ((lane & 3) << 3) | (((lane >> 2) & 3) << 6) | (((lane >> 4) & 1) << 5) | (((lane >> 5) & 1) << 8); }
constexpr int v_rd_off(int d0, int ks, int half) { return d0 * 512 + ks * 2048 + half * 1024; }
template <int OFF> __device__ __forceinline__ s16x4 tr_read(int vb) {
    s16x4 r; asm volatile("ds_read_b64_tr_b16 %0, %1 offset:%2" : "=&v"(r) : "v"(vb), "i"(OFF) : "memory"); return r;
}
template <int D0> __device__ __forceinline__ void pv_one(f32x16& od, int vb, bf16x8 pa0, bf16x8 pa1, bf16x8 pa2, bf16x8 pa3) {
    const s16x4 l0 = tr_read<v_rd_off(D0, 0, 0)>(vb), h0 = tr_read<v_rd_off(D0, 0, 1)>(vb), l1 = tr_read<v_rd_off(D0, 1, 0)>(vb), h1 = tr_read<v_rd_off(D0, 1, 1)>(vb);
    const s16x4 l2 = tr_read<v_rd_off(D0, 2, 0)>(vb), h2 = tr_read<v_rd_off(D0, 2, 1)>(vb), l3 = tr_read<v_rd_off(D0, 3, 0)>(vb), h3 = tr_read<v_rd_off(D0, 3, 1)>(vb);
    asm volatile("s_waitcnt lgkmcnt(0)" ::: "memory"); SBAR();
#define PK(L, H) (bf16x8){L[0], L[1], L[2], L[3], H[0], H[1], H[2], H[3]}
    od = __builtin_amdgcn_mfma_f32_32x32x16_bf16(pa0, PK(l0, h0), od, 0, 0, 0);
    od = __builtin_amdgcn_mfma_f32_32x32x16_bf16(pa1, PK(l1, h1), od, 0, 0, 0);
    od = __builtin_amdgcn_mfma_f32_32x32x16_bf16(pa2, PK(l2, h2), od, 0, 0, 0);
    od = __builtin_amdgcn_mfma_f32_32x32x16_bf16(pa3, PK(l3, h3), od, 0, 0, 0);
#undef PK
}
__device__ __forceinline__ void pv2(f32x16* o, int vb, bf16x8 pa0, bf16x8 pa1, bf16x8 pa2, bf16x8 pa3) {
    pv_one<0>(o[0], vb, pa0, pa1, pa2, pa3); pv_one<1>(o[1], vb, pa0, pa1, pa2, pa3);
}

namespace mla {
constexpr int KROW = 272, SHM_V = 8192, SHM_K = 64 * KROW, NSLOT = 3, OFF_V = 0, OFF_K = NSLOT * SHM_V, OFF_WS = OFF_K + NSLOT * SHM_K;
constexpr int QROW = 208, OFF_Q = OFF_WS + 2048, Q_WAVE = 32 * QROW;
struct VFrag { s16x4 l[2][4], h[2][4]; };
__device__ __forceinline__ void vread(VFrag& f, int vb) {
#define VR(D0, KS) f.l[D0][KS] = tr_read<v_rd_off(D0, KS, 0)>(vb); f.h[D0][KS] = tr_read<v_rd_off(D0, KS, 1)>(vb)
    VR(0, 0); VR(0, 1); VR(0, 2); VR(0, 3); VR(1, 0); VR(1, 1); VR(1, 2); VR(1, 3);
#undef VR
}
template <int B_> __device__ __forceinline__ void kread(bf16x8* kf, bf16x8* qf, const char* kb, const char* qb) {
#pragma unroll
    for (int i = 0; i < 2; ++i) { kf[2 * i] = *reinterpret_cast<const bf16x8*>(kb + (2 * B_ + i) * 32); kf[2 * i + 1] = *reinterpret_cast<const bf16x8*>(kb + 32 * KROW + (2 * B_ + i) * 32);
        qf[i] = *reinterpret_cast<const bf16x8*>(qb + (2 * B_ + i) * 32); }
}
template <int D0> __device__ __forceinline__ void pv_mma(f32x16& od, const VFrag& f, bf16x8 pa0, bf16x8 pa1, bf16x8 pa2, bf16x8 pa3) {
#define PK(L, H) (bf16x8){L[0], L[1], L[2], L[3], H[0], H[1], H[2], H[3]}
    od = __builtin_amdgcn_mfma_f32_32x32x16_bf16(pa0, PK(f.l[D0][0], f.h[D0][0]), od, 0, 0, 0);
    od = __builtin_amdgcn_mfma_f32_32x32x16_bf16(pa1, PK(f.l[D0][1], f.h[D0][1]), od, 0, 0, 0);
    od = __builtin_amdgcn_mfma_f32_32x32x16_bf16(pa2, PK(f.l[D0][2], f.h[D0][2]), od, 0, 0, 0);
    od = __builtin_amdgcn_mfma_f32_32x32x16_bf16(pa3, PK(f.l[D0][3], f.h[D0][3]), od, 0, 0, 0);
#undef PK
}
#define MLA_BAR() asm volatile("s_waitcnt lgkmcnt(0)\n\ts_barrier" ::: "memory")
#define LWAIT() do { asm volatile("s_waitcnt lgkmcnt(0)" ::: "memory"); SBAR(); } while (0)
__device__ __forceinline__ void unit(const bf16_t* __restrict__ Qg, const bf16_t* __restrict__ KVg, const bf16_t* __restrict__ KRg, bf16_t* __restrict__ Og, const f32x2* __restrict__ rope,
                                     int tok0, int seq, int h, int qb, char* lds, const int tid) {
    const int wid = __builtin_amdgcn_readfirstlane(tid >> 6), lane = tid & 63, r32 = lane & 31, hi = lane >> 5;
    const int grp = wid >> 2;
    char* V_lds = lds + OFF_V; char* K_lds = lds + OFF_K;
    float* al_l = (float*)(lds + OFF_WS) + wid * 64;
    f32x16 o[3]; o[0] = f32x16{}; o[1] = f32x16{}; o[2] = f32x16{}; bf16x8 qr[6];
    f32x16 negm = f32x16{};
    const bf16_t* Qw = Qg + (size_t)(tok0 + qb * 256 + wid * 32 + r32) * NQ + h * 96 + hi * 8;
#pragma unroll
    for (int d0 = 0; d0 < 6; ++d0) qr[d0] = *reinterpret_cast<const bf16x8*>(Qw + d0 * 16);
    {
        const f32x4* rp = (const f32x4*)(rope + (size_t)(qb * 256 + wid * 32 + r32) * 16 + 8 * hi);
        u32x4 a = *reinterpret_cast<u32x4*>(&qr[4]), b = *reinterpret_cast<u32x4*>(&qr[5]);
#pragma unroll
        for (int p = 0; p < 4; ++p) { const f32x4 cs = rp[p];
            const float x1a = bf_lo(a[p]), x1b = bf_hi(a[p]), x2a = bf_lo(b[p]), x2b = bf_hi(b[p]);
            a[p] = cvt_pk_bf16(x1a * cs[0] - x2a * cs[1], x1b * cs[2] - x2b * cs[3]);
            b[p] = cvt_pk_bf16(x2a * cs[0] + x1a * cs[1], x2b * cs[2] + x1b * cs[3]); }
        qr[4] = *reinterpret_cast<bf16x8*>(&a); qr[5] = *reinterpret_cast<bf16x8*>(&b);
    }
    char* qbw = lds + OFF_Q + wid * Q_WAVE + r32 * QROW + hi * 16;
#pragma unroll
    for (int d0 = 0; d0 < 6; ++d0) *reinterpret_cast<bf16x8*>(qbw + d0 * 32) = qr[d0];
    const char* qb_ = qbw;
    const int srow = tid >> 3, sc = (tid & 7) * 8;
    const bf16_t* kvp = KVg + (size_t)(tok0 + srow) * NKV + h * 128 + sc;
    const int rrow = (tid >> 2) & 63, rc = (tid & 3) * 8;
    const bf16_t* krp = KRg + (size_t)(tok0 + rrow) * 32 + rc;
    const int vst = v_st_nat(srow, sc), kst = srow * KROW + sc * 2, rst = rrow * KROW + (64 + rc) * 2;
    const bool do_r = wid < 4;
    const int vb0 = (int)(uintptr_t)V_lds + v_rd_base(lane);
    const char* kb0 = K_lds + r32 * KROW + hi * 16;
    const u32x4 ones_u = {0x3f803f80u, 0x3f803f80u, 0x3f803f80u, 0x3f803f80u}; const bf16x8 ones = *reinterpret_cast<const bf16x8*>(&ones_u);
    bf16x8 sv, sk, sr; sr = bf16x8{};
#define SLOAD(k0) do { sv = *reinterpret_cast<const bf16x8*>(kvp + (size_t)(k0) * NKV + 64); sk = *reinterpret_cast<const bf16x8*>(kvp + (size_t)(k0) * NKV); if (do_r) sr = *reinterpret_cast<const bf16x8*>(krp + (size_t)(k0) * 32); } while (0)
#define SWRITE(s) do { *(bf16x8*)(V_lds + (s) * SHM_V + vst) = sv; *(bf16x8*)(K_lds + (s) * SHM_K + kst) = sk; if (do_r) *(bf16x8*)(K_lds + (s) * SHM_K + rst) = sr; } while (0)
#define SOFTMAX_Y(FIRST) do { \
    float rm; {   \
      float ca = fmaxf(fmaxf(p0[0], p0[1]), p0[2]), cb = fmaxf(fmaxf(p0[8], p0[9]), p0[10]), cc = fmaxf(fmaxf(p1[0], p1[1]), p1[2]), cd = fmaxf(fmaxf(p1[8], p1[9]), p1[10]); \
      ca = fmaxf(fmaxf(ca, p0[3]), p0[4]); cb = fmaxf(fmaxf(cb, p0[11]), p0[12]); cc = fmaxf(fmaxf(cc, p1[3]), p1[4]); cd = fmaxf(fmaxf(cd, p1[11]), p1[12]); \
      ca = fmaxf(fmaxf(ca, p0[5]), p0[6]); cb = fmaxf(fmaxf(cb, p0[13]), p0[14]); cc = fmaxf(fmaxf(cc, p1[5]), p1[6]); cd = fmaxf(fmaxf(cd, p1[13]), p1[14]); \
      ca = fmaxf(ca, p0[7]); cb = fmaxf(cb, p0[15]); cc = fmaxf(cc, p1[7]); cd = fmaxf(cd, p1[15]); \
      rm = fmaxf(fmaxf(fmaxf(ca, cb), cc), cd); } \
    { auto rr_ = __builtin_amdgcn_permlane32_swap(__float_as_uint(rm), __float_as_uint(rm), false, false); rm = fmaxf(__uint_as_float(rr_[0]), __uint_as_float(rr_[1])); } \
    if ((FIRST) || __any(rm > SM_THR)) { \
        const float dl = (FIRST) ? rm : fmaxf(rm, 0.f); \
        _Pragma("unroll") for (int r = 0; r < 16; ++r) { p0[r] -= dl; p1[r] -= dl; negm[r] -= dl; } \
        if (!(FIRST)) { const float al_ = __builtin_amdgcn_exp2f(-dl); if (hi == 0) al_l[r32] = al_; asm volatile("s_waitcnt lgkmcnt(0)" ::: "memory"); \
            _Pragma("unroll") for (int d = 0; d < 3; ++d) _Pragma("unroll") for (int r = 0; r < 16; ++r) o[d][r] *= al_l[crow(r, hi)]; } \
    } \
    _Pragma("unroll") for (int r = 0; r < 16; ++r) { p0[r] = __builtin_amdgcn_exp2f(p0[r]); p1[r] = __builtin_amdgcn_exp2f(p1[r]); } \
    PK4_(p0, 0, pa0); PK4_(p0, 8, pa1); PK4_(p1, 0, pa2); PK4_(p1, 8, pa3); } while (0)
#define PK4_(P, BASE, OUT) do { u32x4 w = {cvt_pk_bf16(P[BASE + 0], P[BASE + 1]), cvt_pk_bf16(P[BASE + 2], P[BASE + 3]), cvt_pk_bf16(P[BASE + 4], P[BASE + 5]), cvt_pk_bf16(P[BASE + 6], P[BASE + 7])}; \
    OUT = *reinterpret_cast<bf16x8*>(&w); } while (0)
#define QKA() do { p0 = __builtin_amdgcn_mfma_f32_32x32x16_bf16(kf[0], qf[0], negm, 0, 0, 0); p1 = __builtin_amdgcn_mfma_f32_32x32x16_bf16(kf[1], qf[0], negm, 0, 0, 0); \
    p0 = __builtin_amdgcn_mfma_f32_32x32x16_bf16(kf[2], qf[1], p0, 0, 0, 0); p1 = __builtin_amdgcn_mfma_f32_32x32x16_bf16(kf[3], qf[1], p1, 0, 0, 0); } while (0)
#define QKB() do { p0 = __builtin_amdgcn_mfma_f32_32x32x16_bf16(kf[0], qf[0], p0, 0, 0, 0); p1 = __builtin_amdgcn_mfma_f32_32x32x16_bf16(kf[1], qf[0], p1, 0, 0, 0); \
    p0 = __builtin_amdgcn_mfma_f32_32x32x16_bf16(kf[2], qf[1], p0, 0, 0, 0); p1 = __builtin_amdgcn_mfma_f32_32x32x16_bf16(kf[3], qf[1], p1, 0, 0, 0); } while (0)
#define ONES4() do { o[2] = __builtin_amdgcn_mfma_f32_32x32x16_bf16(pa0, ones, o[2], 0, 0, 0); o[2] = __builtin_amdgcn_mfma_f32_32x32x16_bf16(pa1, ones, o[2], 0, 0, 0); \
    o[2] = __builtin_amdgcn_mfma_f32_32x32x16_bf16(pa2, ones, o[2], 0, 0, 0); o[2] = __builtin_amdgcn_mfma_f32_32x32x16_bf16(pa3, ones, o[2], 0, 0, 0); } while (0)
    f32x16 p0, p1; bf16x8 pa0, pa1, pa2, pa3; const int NT = seq / 64;
    SLOAD(0); SWRITE(0); SLOAD(64); SWRITE(1); if (2 < NT) SLOAD(128);
    __syncthreads();
    if (grp) MLA_BAR();
    bf16x8 kf[4], qf[2]; VFrag vf;
    kread<0>(kf, qf, kb0, qb_); LWAIT(); QKA(); SBAR();
    kread<1>(kf, qf, kb0, qb_); LWAIT(); QKB(); SBAR();
    kread<2>(kf, qf, kb0, qb_); LWAIT(); QKB(); SBAR();
    MLA_BAR();
    vread(vf, vb0); SBAR();
    SOFTMAX_Y(true);
    MLA_BAR();
    int sv_ = 0, sk_ = 1, sw_ = 2;
#pragma unroll 1
    for (int t = 0; t + 1 < NT; ++t) {
        SBAR();
        if (grp) { if (t + 2 < NT) SWRITE(sw_); if (t + 3 < NT) SLOAD((t + 3) * 64); }
        const char* kb = kb0 + sk_ * SHM_K;
        __builtin_amdgcn_s_setprio(1);
        kread<0>(kf, qf, kb, qb_); SBAR();
        pv_mma<0>(o[0], vf, pa0, pa1, pa2, pa3); SBAR();
        LWAIT(); QKA(); SBAR();
        kread<1>(kf, qf, kb, qb_); SBAR();
        ONES4(); SBAR();
        LWAIT(); QKB(); SBAR();
        kread<2>(kf, qf, kb, qb_); SBAR();
        pv_mma<1>(o[1], vf, pa0, pa1, pa2, pa3); SBAR();
        LWAIT(); QKB(); SBAR();
        __builtin_amdgcn_s_setprio(0);
        MLA_BAR();
        vread(vf, vb0 + sk_ * SHM_V); SBAR();
        if (!grp) { if (t + 2 < NT) SWRITE(sw_); if (t + 3 < NT) SLOAD((t + 3) * 64); }
        SBAR();
        SOFTMAX_Y(false);
        SBAR();
        MLA_BAR();
        { const int tmp = sv_; sv_ = sk_; sk_ = sw_; sw_ = tmp; }
    }
    SBAR();
    pv_mma<0>(o[0], vf, pa0, pa1, pa2, pa3); pv_mma<1>(o[1], vf, pa0, pa1, pa2, pa3); ONES4();
    MLA_BAR();
    if (!grp) MLA_BAR();
    bf16_t* stg = (bf16_t*)K_lds + wid * 2048;
#pragma unroll
    for (int r = 0; r < 16; ++r) { const int orow = crow(r, hi); const float rl = __builtin_amdgcn_rcpf(o[2][r]);
#pragma unroll
        for (int d0 = 0; d0 < 2; ++d0) stg[orow * 64 + d0 * 32 + r32] = f2bf(o[d0][r] * rl); }
    asm volatile("s_waitcnt lgkmcnt(0)" ::: "memory");
    bf16_t* Ow = Og + (size_t)(tok0 + qb * 256 + wid * 32) * DM + h * 64;
#pragma unroll
    for (int i = 0; i < 4; ++i) { const int row = i * 8 + (lane >> 3), ch = lane & 7; const u32x4 v = *(const u32x4*)(stg + row * 64 + ch * 8); *(u32x4*)(Ow + (size_t)row * DM + ch * 8) = v; }
    __syncthreads();
#undef SLOAD
#undef SWRITE
#undef SOFTMAX_Y
#undef PK4_
#undef QKA
#undef QKB
#undef ONES4
}
__device__ __forceinline__ void phase(const bf16_t* Q, const bf16_t* KV, const bf16_t* KR, bf16_t* O, const f32x2* rope, char* lds, const int tid, const int b, const int G) {
    if (G == 256) {
        const int xcd = b & 7, c = b >> 3;
        for (int i = 0; i < 16; ++i) unit(Q, KV, KR, O, rope, xcd * 8192, 8192, i, c, lds, tid);
        for (int j = 0; j < 8; ++j) unit(Q, KV, KR, O, rope, TP + xcd * 4096, 4096, 2 * j + (c >> 4), c & 15, lds, tid);
    } else {
        for (int u = b; u < 4096 + 2048; u += G) {
            if (u < 4096) unit(Q, KV, KR, O, rope, (u >> 9) * 8192, 8192, (u >> 5) & 15, u & 31, lds, tid);
            else { const int v = u - 4096; unit(Q, KV, KR, O, rope, TP + (v >> 8) * 4096, 4096, (v >> 4) & 15, v & 15, lds, tid); }
        }
    }
}
}

namespace na {
constexpr int KRB = 144, SLOT_K = 128 * KRB, SLOT_V = 16384, SLOT = SLOT_K + SLOT_V, NSL = 3, OFF_BIAS = NSL * SLOT, OFF_WS = OFF_BIAS + 29760;
template <int OFF> __device__ __forceinline__ s16x4 trr(int vb) { s16x4 r; asm volatile("ds_read_b64_tr_b16 %0, %1 offset:%2" : "=&v"(r) : "v"(vb), "i"(OFF) : "memory"); return r; }
constexpr int vro(int d0, int ks, int half) { return d0 * 512 + half * 1024 + (ks & 1) * 2048 + (ks >> 1) * 8192; }
template <int D0> __device__ __forceinline__ void pv_blk(f32x16& od, int vb, bf16x8 pa0, bf16x8 pa1, bf16x8 pa2, bf16x8 pa3) {
    const s16x4 l0 = trr<vro(D0, 0, 0)>(vb), h0 = trr<vro(D0, 0, 1)>(vb), l1 = trr<vro(D0, 1, 0)>(vb), h1 = trr<vro(D0, 1, 1)>(vb);
    const s16x4 l2 = trr<vro(D0, 2, 0)>(vb), h2 = trr<vro(D0, 2, 1)>(vb), l3 = trr<vro(D0, 3, 0)>(vb), h3 = trr<vro(D0, 3, 1)>(vb);
    asm volatile("s_waitcnt lgkmcnt(0)" ::: "memory"); SBAR();
#define PK(L, H) (bf16x8){L[0], L[1], L[2], L[3], H[0], H[1], H[2], H[3]}
    od = __builtin_amdgcn_mfma_f32_32x32x16_bf16(pa0, PK(l0, h0), od, 0, 0, 0);
    od = __builtin_amdgcn_mfma_f32_32x32x16_bf16(pa1, PK(l1, h1), od, 0, 0, 0);
    od = __builtin_amdgcn_mfma_f32_32x32x16_bf16(pa2, PK(l2, h2), od, 0, 0, 0);
    od = __builtin_amdgcn_mfma_f32_32x32x16_bf16(pa3, PK(l3, h3), od, 0, 0, 0);
#undef PK
}
__device__ __forceinline__ void phase(const bf16_t* __restrict__ QKV, bf16_t* __restrict__ Og, const float* __restrict__ rpb, char* lds, const int tid, const int bid, const int G) {
    const int wid = __builtin_amdgcn_readfirstlane(tid >> 6), lane = tid & 63, r32 = lane & 31, hi = lane >> 5;
    float* bias = (float*)(lds + OFF_BIAS);
    for (int i = tid; i < 16 * 15 * 31; i += 512) bias[i] = rpb[i] * LOG2E;
    float* al_l = (float*)(lds + OFF_WS) + wid * 32;
    const int g = wid & 3, kc0 = min(max(16 * g - 8, 0), 32);
    const int qcol = 16 * g + (r32 & 15), cs = min(max(qcol - 8, 0), 48);
    const int tw = kc0 + 4 * hi - cs;
    const int kbw = (kc0 + r32) * KRB + hi * 16;
    const int vbw = (int)(uintptr_t)lds + SLOT_K + (kc0 >> 3) * 1024 + v_rd_base(lane);
    const int srho0 = tid >> 3, sdc = (tid & 7) * 8;
    const int kst0 = srho0 * KRB + sdc * 2, kst1 = (srho0 + 64) * KRB + sdc * 2;
    const int scol = srho0 & 63;
    const int vst0 = SLOT_K + (((srho0 >> 6) * 8 + (scol >> 3)) * 2 + (sdc >> 5)) * 512 + ((scol & 7) * 32 + (sdc & 31)) * 2, vst1 = vst0 + 8192;
    const int nunits = 6144, per = (nunits + G - 1) / G;
#pragma unroll 1
    for (int ii = 0; ii < per; ++ii) {
        int h, rg, rows, tokb;
        if (G == 256) {
            const int xcd = bid & 7, c = bid >> 3;
            if (ii < 16) { h = ii; rg = c; rows = 128; tokb = xcd * 8192; } else { h = 2 * (ii - 16) + (c >> 4); rg = c & 15; rows = 64; tokb = TP + xcd * 4096; }
        } else {
            const int u = bid * per + ii; if (u >= nunits) break;
            h = u & 15; int gg = u >> 4;
            if (gg < 256) { rg = gg & 31; rows = 128; tokb = (gg >> 5) * 8192; } else { gg -= 256; rg = gg & 15; rows = 64; tokb = TP + (gg >> 4) * 4096; }
        }
        const int r0 = rg * 4, rsb = min(max(r0 - 4, 0), rows - 8);
        const int r = r0 + 2 * (wid >> 2);
        const int rs0 = min(max(r - 4, 0), rows - 8), rs1 = min(max(r - 3, 0), rows - 8);
        const int toff = (rs0 - rsb) >> 1;
        const int ntile = 5 + ((min(max(r0 - 2, 0), rows - 8) - rsb) >> 1);
        const int qrow = r + ((r32 >> 4) & 1), rsq = (r32 & 16) ? rs1 : rs0;
        const bf16_t* qp = QKV + (size_t)(tokb + qrow * 64 + qcol) * 3072 + h * 64 + hi * 8;
        bf16x8 qr[4];
#pragma unroll
        for (int d0 = 0; d0 < 4; ++d0) qr[d0] = *reinterpret_cast<const bf16x8*>(qp + d0 * 16);
        const bf16_t* gbase = QKV + (size_t)tokb * 3072 + 1024 + h * 64 + (size_t)scol * 3072 + sdc;
        bf16x8 sk0, sk1, sv0, sv1;
#define NA_GLOAD(tau) do { const int ra_ = min(rsb + 2 * (tau), rows - 1), rb_ = min(rsb + 2 * (tau) + 1, rows - 1); \
            const bf16_t* pa_ = gbase + (size_t)ra_ * (64 * 3072); const bf16_t* pb_ = gbase + (size_t)rb_ * (64 * 3072); \
            sk0 = *reinterpret_cast<const bf16x8*>(pa_); sv0 = *reinterpret_cast<const bf16x8*>(pa_ + 1024); sk1 = *reinterpret_cast<const bf16x8*>(pb_); sv1 = *reinterpret_cast<const bf16x8*>(pb_ + 1024); } while (0)
#define NA_LWRITE(slot) do { char* sb_ = lds + (slot) * SLOT; *(bf16x8*)(sb_ + kst0) = sk0; *(bf16x8*)(sb_ + kst1) = sk1; *(bf16x8*)(sb_ + vst0) = sv0; *(bf16x8*)(sb_ + vst1) = sv1; } while (0)
        __syncthreads();
        NA_GLOAD(0); NA_LWRITE(0); NA_GLOAD(1); NA_LWRITE(1); NA_GLOAD(2);
        float m_reg = -1e30f, l_reg = 0.f; f32x16 o[2]; o[0] = f32x16{}; o[1] = f32x16{};
        const float* bh = bias + h * (15 * 31);
        int s0 = 0, s1 = 1, s2 = 2;
#pragma unroll 1
        for (int s = 0; s < 5; ++s) {
            __syncthreads();
            if (s + 2 < ntile) NA_LWRITE(s2);
            if (s + 3 < ntile) NA_GLOAD(s + 3);
            SBAR();
            const int slot = toff ? s1 : s0;
            const char* kb = lds + slot * SLOT + kbw;
            bf16x8 ka[8];
#pragma unroll
            for (int d0 = 0; d0 < 4; ++d0) { ka[d0] = *reinterpret_cast<const bf16x8*>(kb + d0 * 32); ka[4 + d0] = *reinterpret_cast<const bf16x8*>(kb + 64 * KRB + d0 * 32); }
            f32x16 p0 = f32x16{}, p1 = f32x16{};
#pragma unroll
            for (int d0 = 0; d0 < 4; ++d0) { p0 = __builtin_amdgcn_mfma_f32_32x32x16_bf16(ka[d0], qr[d0], p0, 0, 0, 0); p1 = __builtin_amdgcn_mfma_f32_32x32x16_bf16(ka[4 + d0], qr[d0], p1, 0, 0, 0); }
            const int kra = rs0 + 2 * s;
            const bool oka = (unsigned)(kra - rsq) < 8u, okb = (unsigned)(kra + 1 - rsq) < 8u;
            const float* bl = bh + (kra - qrow + 7) * 31 + (kc0 + 4 * hi - qcol + 15);
#pragma unroll
            for (int rr = 0; rr < 16; ++rr) { const int k0 = (rr & 3) + 8 * (rr >> 2); const bool okc = (unsigned)(tw + k0) < 16u;
                p0[rr] = (okc && oka) ? p0[rr] + bl[k0] : -1e30f;
                p1[rr] = (okc && okb) ? p1[rr] + bl[k0 + 31] : -1e30f; }
            float mn, alpha; partialSM(p0, p1, m_reg, mn, alpha);
#pragma unroll
            for (int rr = 0; rr < 16; ++rr) p1[rr] = __builtin_amdgcn_exp2f(p1[rr]);
            { float ps = 0.f;
#pragma unroll
              for (int rr = 0; rr < 16; ++rr) ps += p0[rr] + p1[rr];
              auto sw = __builtin_amdgcn_permlane32_swap(__float_as_uint(ps), __float_as_uint(ps), false, false); l_reg = l_reg * alpha + (__uint_as_float(sw[0]) + __uint_as_float(sw[1])); }
            bf16x8 pa0, pa1, pa2, pa3;
#define PKD(P, B, OUT) do { u32x4 w_ = {cvt_pk_bf16(P[B + 0], P[B + 1]), cvt_pk_bf16(P[B + 2], P[B + 3]), cvt_pk_bf16(P[B + 4], P[B + 5]), cvt_pk_bf16(P[B + 6], P[B + 7])}; OUT = *reinterpret_cast<bf16x8*>(&w_); } while (0)
            PKD(p0, 0, pa0); PKD(p0, 8, pa1); PKD(p1, 0, pa2); PKD(p1, 8, pa3);
#undef PKD
            if (__any(alpha < 1.f)) { if (hi == 0) al_l[r32] = alpha; asm volatile("s_waitcnt lgkmcnt(0)" ::: "memory");
#pragma unroll
                for (int d = 0; d < 2; ++d)
#pragma unroll
                    for (int rr = 0; rr < 16; ++rr) o[d][rr] *= al_l[crow(rr, hi)]; }
            SBAR();
            const int vb = vbw + slot * SLOT;
            pv_blk<0>(o[0], vb, pa0, pa1, pa2, pa3); pv_blk<1>(o[1], vb, pa0, pa1, pa2, pa3);
            { const int t_ = s0; s0 = s1; s1 = s2; s2 = t_; }
        }
#undef NA_GLOAD
#undef NA_LWRITE
        if (hi == 0) al_l[r32] = l_reg; asm volatile("s_waitcnt lgkmcnt(0)" ::: "memory");
        bf16_t* Ow = Og + (size_t)(tokb + r * 64 + 16 * g) * DM + h * 64;
#pragma unroll
        for (int rr = 0; rr < 16; ++rr) { const int q = crow(rr, hi); const float rl = __builtin_amdgcn_rcpf(al_l[q]); bf16_t* op = Ow + (size_t)((q >> 4) * 64 + (q & 15)) * DM + r32;
            op[0] = f2bf(o[0][rr] * rl); op[32] = f2bf(o[1][rr] * rl); }
        asm volatile("s_waitcnt lgkmcnt(0)" ::: "memory");
    }
}
}

#define XB_TMO      128
#define XB_XCNT(j)  (256  + 64 * (j))
#define XB_XSUB(j)  (1280 + 64 * (j))
#define XB_XGEN(j)  (2304 + 64 * (j))
#define XB_TOP      3328
#define XB_TOPGEN   3392
#define XCD_BAR_WORDS 3456
#define XB_SPIN_CAP (1u << 18)

__device__ __forceinline__ unsigned xb_ld(unsigned* p)              { return __hip_atomic_load(p, __ATOMIC_RELAXED, __HIP_MEMORY_SCOPE_AGENT); }
__device__ __forceinline__ unsigned xb_add(unsigned* p, unsigned v) { return __hip_atomic_fetch_add(p, v, __ATOMIC_RELAXED, __HIP_MEMORY_SCOPE_AGENT); }
__device__ __forceinline__ unsigned xb_xcc_id() { return (unsigned)__builtin_amdgcn_s_getreg((3 << 11) | 20) & 0xFu; }
#define XB_SPIN(cond, bar) do { unsigned _sp = 0; while (cond) { __builtin_amdgcn_s_sleep(1); \
    if ((++_sp & 255u) == 0u) { if (xb_ld(&(bar)[XB_TMO])) break; if (_sp > XB_SPIN_CAP) { atomicAdd(&(bar)[XB_TMO], 1u); break; } } } } while (0)

struct XcdBarrier {
    unsigned* bar; unsigned x;
    volatile LAS unsigned* st;
};

__device__ __forceinline__ XcdBarrier xcd_barrier_post(unsigned* bar, volatile LAS unsigned* st) {
    XcdBarrier b; b.bar = bar; b.x = xb_xcc_id(); b.st = st;
    if (threadIdx.x == 0) (void)xb_add(&bar[XB_XCNT(b.x)], 1u);
    return b;
}
__device__ __forceinline__ void xcd_barrier_complete(unsigned* bar, unsigned x, unsigned& nloc, unsigned& nx) {
    const unsigned G = gridDim.x * gridDim.y * gridDim.z;
    unsigned sum, cnt, mine, sp = 0u;
    for (;;) {
        sum = 0u; cnt = 0u; mine = 0u;
#pragma unroll
        for (unsigned j = 0; j < 16; ++j) { const unsigned c = xb_ld(&bar[XB_XCNT(j)]); sum += c; cnt += (c > 0u) ? 1u : 0u; mine = (j == x) ? c : mine; }
        if (sum == G) break;
        __builtin_amdgcn_s_sleep(1);
        if ((++sp & 255u) == 0u) { if (xb_ld(&bar[XB_TMO])) break; if (sp > XB_SPIN_CAP) { atomicAdd(&bar[XB_TMO], 1u); break; } }
    }
    nloc = mine > 0u ? mine : 1u; nx = cnt > 0u ? cnt : 1u;
}

__device__ __forceinline__ void xcd_barrier(const XcdBarrier& b) {
    asm volatile("s_waitcnt vmcnt(0)" ::: "memory");
    __syncthreads();
    if (threadIdx.x == 0) {
        unsigned* bar = b.bar;
        __builtin_amdgcn_s_waitcnt(0);
        unsigned nloc = b.st[0], nx = b.st[1];
        if (nloc == 0u) { xcd_barrier_complete(bar, b.x, nloc, nx); b.st[0] = nloc; b.st[1] = nx; }
        const unsigned old = xb_add(&bar[XB_XSUB(b.x)], 1u);
        const unsigned gen = old / nloc;
        if (old + 1u == (gen + 1u) * nloc) {
            __builtin_amdgcn_fence(__ATOMIC_RELEASE, "agent");
            asm volatile("s_waitcnt vmcnt(0)" ::: "memory");
            const unsigned og = xb_add(&bar[XB_TOP], 1u);
            const unsigned tg = og / nx;
            if (og + 1u == (tg + 1u) * nx) xb_add(&bar[XB_TOPGEN], 1u);
            else XB_SPIN(xb_ld(&bar[XB_TOPGEN]) == tg, bar);
            __builtin_amdgcn_fence(__ATOMIC_ACQUIRE, "agent");
            xb_add(&bar[XB_XGEN(b.x)], 1u);
            asm volatile("s_waitcnt vmcnt(0)" ::: "memory");
        } else {
            XB_SPIN(xb_ld(&bar[XB_XGEN(b.x)]) == gen, bar);
            __builtin_amdgcn_fence(__ATOMIC_ACQUIRE, "agent");
            asm volatile("s_waitcnt vmcnt(0)" ::: "memory");
        }
    }
    __syncthreads();
}


struct RowP { const float* xin0; const float* xin1; const bf16_t* h; const float* gpost; const float* gate; float* xout; bf16_t* hn; const float* g2; const float* scale; const float* shift; };
template <bool HAS_H, bool HAS_HN, bool XIN_BF, bool XOUT_BF>
__device__ __forceinline__ void rowpass(const RowP P, int gw, int ngw, int lane) {
    const int rpw = (T + ngw - 1) / ngw; const int r0 = gw * rpw, r1 = min(T, r0 + rpw);
    int cur_bb = -1; f32x4 A[4], B[4], C[4];
#pragma unroll
    for (int j = 0; j < 4; ++j) { A[j] = f32x4{}; B[j] = f32x4{}; C[j] = f32x4{}; }
    for (int t = r0; t < r1; ++t) {
        const int bb = tok_bb(t);
        if (bb != cur_bb) { cur_bb = bb;
#pragma unroll
            for (int j = 0; j < 4; ++j) { const int col = 4 * lane + 256 * j;
                if (HAS_H) A[j] = *(const f32x4*)(P.gpost + col) * *(const f32x4*)(P.gate + (size_t)bb * 6144 + col);
                if (HAS_HN) { B[j] = *(const f32x4*)(P.g2 + col) * (*(const f32x4*)(P.scale + (size_t)bb * 6144 + col) + 1.f); C[j] = *(const f32x4*)(P.shift + (size_t)bb * 6144 + col); } } }
        f32x4 xv[4];
        if (XIN_BF) { const bf16_t* xb = (const bf16_t*)(P.xout + (size_t)t * DM);
#pragma unroll
            for (int j = 0; j < 4; ++j) { const u32x2 w = *(const u32x2*)(xb + 4 * lane + 256 * j); xv[j] = (f32x4){bf_lo(w.x), bf_hi(w.x), bf_lo(w.y), bf_hi(w.y)}; }
        } else { const float* xr = t < TP ? P.xin0 + (size_t)t * DM : P.xin1 + (size_t)(t - TP) * DM;
#pragma unroll
            for (int j = 0; j < 4; ++j) xv[j] = __builtin_nontemporal_load((const f32x4*)(xr + 4 * lane + 256 * j)); }
        if (HAS_H) {
            const bf16_t* hr = P.h + (size_t)t * DM; f32x4 hv[4]; float ss = 0.f;
#pragma unroll
            for (int j = 0; j < 4; ++j) { const u32x2 w = __builtin_nontemporal_load((const u32x2*)(hr + 4 * lane + 256 * j)); hv[j] = (f32x4){bf_lo(w.x), bf_hi(w.x), bf_lo(w.y), bf_hi(w.y)};
                ss += (hv[j][0] * hv[j][0] + hv[j][1] * hv[j][1]) + (hv[j][2] * hv[j][2] + hv[j][3] * hv[j][3]); }
            const float rstd = __builtin_amdgcn_rsqf(wave_sum(ss) * (1.f / DM) + RMS_EPS);
            float* xo = P.xout + (size_t)t * DM;
#pragma unroll
            for (int j = 0; j < 4; ++j) { xv[j] = xv[j] + A[j] * (hv[j] * rstd);
                if (XOUT_BF) { u32x2 w; w.x = cvt_pk_bf16(xv[j][0], xv[j][1]); w.y = cvt_pk_bf16(xv[j][2], xv[j][3]); *(u32x2*)((bf16_t*)xo + 4 * lane + 256 * j) = w; }
                else __builtin_nontemporal_store(xv[j], (f32x4*)(xo + 4 * lane + 256 * j)); }
        }
        if (HAS_HN) {
            float ss = 0.f;
#pragma unroll
            for (int j = 0; j < 4; ++j) ss += (xv[j][0] * xv[j][0] + xv[j][1] * xv[j][1]) + (xv[j][2] * xv[j][2] + xv[j][3] * xv[j][3]);
            const float rstd = __builtin_amdgcn_rsqf(wave_sum(ss) * (1.f / DM) + RMS_EPS);
            bf16_t* ho = P.hn + (size_t)t * DM;
#pragma unroll
            for (int j = 0; j < 4; ++j) { const f32x4 v = xv[j] * rstd * B[j] + C[j]; u32x2 w; w.x = cvt_pk_bf16(v[0], v[1]); w.y = cvt_pk_bf16(v[2], v[3]); *(u32x2*)(ho + 4 * lane + 256 * j) = w; }
        }
    }
}
__device__ __forceinline__ void lat_rowpass(const float* lat, const float* qn, const float* kvn, const f32x2* rope, bf16_t* CQ, bf16_t* CKV, bf16_t* KR, int gw, int ngw, int lane) {
    const int rpw = (T + ngw - 1) / ngw; const int r0 = gw * rpw, r1 = min(T, r0 + rpw);
    const f32x4 qg = *(const f32x4*)(qn + 4 * lane); const f32x2 kg = *(const f32x2*)(kvn + 2 * lane);
    for (int t = r0; t < r1; ++t) {
        const float* lr = lat + (size_t)t * NLAT;
        const f32x4 q = *(const f32x4*)(lr + 4 * lane); const f32x2 k = *(const f32x2*)(lr + 256 + 2 * lane);
        float x1 = 0.f, x2 = 0.f; if (lane < 16) { x1 = lr[384 + lane]; x2 = lr[400 + lane]; }
        float sq = (q[0] * q[0] + q[1] * q[1]) + (q[2] * q[2] + q[3] * q[3]), sk = k[0] * k[0] + k[1] * k[1];
#pragma unroll
        for (int o = 1; o < 64; o <<= 1) { sq += __shfl_xor(sq, o); sk += __shfl_xor(sk, o); }
        const float rq = __builtin_amdgcn_rsqf(sq * (1.f / 256.f) + RMS_EPS), rk = __builtin_amdgcn_rsqf(sk * (1.f / 128.f) + RMS_EPS);
        u32x2 wq; wq.x = cvt_pk_bf16(q[0] * rq * qg[0], q[1] * rq * qg[1]); wq.y = cvt_pk_bf16(q[2] * rq * qg[2], q[3] * rq * qg[3]);
        *(u32x2*)(CQ + (size_t)t * 256 + 4 * lane) = wq;
        *(unsigned*)(CKV + (size_t)t * 128 + 2 * lane) = cvt_pk_bf16(k[0] * rk * kg[0], k[1] * rk * kg[1]);
        if (lane < 16) { const f32x2 cs = rope[(size_t)tok_pos(t) * 16 + lane];
            KR[(size_t)t * 32 + lane] = f2bf(x1 * cs.x - x2 * cs.y); KR[(size_t)t * 32 + 16 + lane] = f2bf(x2 * cs.x + x1 * cs.y); }
    }
}

__device__ __forceinline__ void transpose_item(const float* W, int K, int N, bf16_t* WT, int k0, int n0, int drow0, LAS float* scr, int lane) {
#pragma unroll 8
    for (int i = 0; i < 32; ++i) { const int kk = 2 * i + (lane >> 5); scr[kk * 33 + (lane & 31)] = __builtin_nontemporal_load(W + (size_t)(k0 + kk) * N + n0 + (lane & 31)); }
    asm volatile("s_waitcnt lgkmcnt(0)" ::: "memory");
    const int c = lane & 7;
#pragma unroll
    for (int j = 0; j < 4; ++j) { const int n = (lane >> 3) + 8 * j; const LAS float* s = scr + (8 * c) * 33 + n;
        u32x4 o; o.x = cvt_pk_bf16(s[0 * 33], s[1 * 33]); o.y = cvt_pk_bf16(s[2 * 33], s[3 * 33]); o.z = cvt_pk_bf16(s[4 * 33], s[5 * 33]); o.w = cvt_pk_bf16(s[6 * 33], s[7 * 33]);
        *(u32x4*)(WT + (size_t)(drow0 + n) * K + k0 + 8 * c) = o; }
    asm volatile("s_waitcnt lgkmcnt(0)" ::: "memory");
}

struct Args { const float* in[21]; float* out; unsigned char* ws; int ph_lo, ph_hi; };
constexpr int N_PHASES = 19;

__global__ void __launch_bounds__(512, 2) fwd_kernel(Args args) {
    extern __shared__ __attribute__((aligned(16))) unsigned char lds[];
    cg::grid_group grid = cg::this_grid();
    if (threadIdx.x < 4) ((LAS unsigned*)((LAS unsigned char*)lds + LDS_ST_OFF))[threadIdx.x] = 0u;
    __syncthreads();
    const XcdBarrier xbar = xcd_barrier_post((unsigned*)(args.ws + WS_BAR), (volatile LAS unsigned*)((LAS unsigned char*)lds + LDS_ST_OFF));
    const int ph_lo = args.ph_lo, ph_hi = args.ph_hi;
    int rep_done = 0;
    for (int ph = ph_lo; ph < ph_hi; ++ph) {
        const unsigned char __attribute__((address_space(4)))* kp = (const unsigned char __attribute__((address_space(4)))*)__builtin_amdgcn_kernarg_segment_ptr();
        asm volatile("" : "+s"(kp));
        int tid = threadIdx.x, bid = blockIdx.x, G = gridDim.x;
        asm volatile("" : "+v"(tid)); asm volatile("" : "+s"(bid)); asm volatile("" : "+s"(G));
        const int lane = tid & 63, wid = __builtin_amdgcn_readfirstlane(tid >> 6);
        const int gw = bid * 8 + wid, ngw = G * 8;
#define AIN(i) (*(const float* const __attribute__((address_space(4)))*)(kp + 8 * (i)))
        float* out = *(float* const __attribute__((address_space(4)))*)(kp + 8 * 21);
        unsigned char* ws = *(unsigned char* const __attribute__((address_space(4)))*)(kp + 8 * 22);
        bf16_t* Wdkv_t = (bf16_t*)(ws + WS_WDKV); bf16_t* Wuq_t = (bf16_t*)(ws + WS_WUQ); bf16_t* Wukv_t = (bf16_t*)(ws + WS_WUKV); bf16_t* Wo_t = (bf16_t*)(ws + WS_WO);
        bf16_t* NAqkv_t = (bf16_t*)(ws + WS_NAQKV); bf16_t* NAo_t = (bf16_t*)(ws + WS_NAO); bf16_t* Wgu_t = (bf16_t*)(ws + WS_WGU); bf16_t* Wdn_t = (bf16_t*)(ws + WS_WDN);
        float* MOD = (float*)(ws + WS_MOD); f32x2* ROPE = (f32x2*)(ws + WS_ROPE);
        bf16_t* HN = (bf16_t*)(ws + WS_HN); bf16_t* OB = HN;
        float* LAT = (float*)(ws + WS_R1); bf16_t* KV = (bf16_t*)(ws + WS_R1); bf16_t* HMIX = (bf16_t*)(ws + WS_R1); bf16_t* QKV = (bf16_t*)(ws + WS_R1);
        bf16_t* HID = (bf16_t*)(ws + WS_HID); bf16_t* QB = (bf16_t*)(ws + WS_Q); bf16_t* KR = (bf16_t*)(ws + WS_KR); bf16_t* CQ = (bf16_t*)(ws + WS_CQ); bf16_t* CKV = (bf16_t*)(ws + WS_CKV);
        const float* x_p = AIN(0); const float* x_s = AIN(1);


        int kind = ph, l = 0; if (ph >= 14) { kind = ph - 7; l = 1; }
        switch (kind) {
        case 0: if (PH_ON(0)) {
            if (bid < 192) {
                float* cact = (float*)lds;
                float* part = (float*)(lds + 65536);
                for (int i = tid; i < 16384; i += 512) { const int bb = i >> 10, k = i & 1023; const float c = bb < 8 ? AIN(2)[bb * 1024 + k] : AIN(3)[(bb - 8) * 1024 + k];
                    cact[k * 16 + bb] = c / (1.f + expf(-c)); }
                __syncthreads();
                const int item = bid, ml = item / 96, n0 = (item % 96) * 64;
                const float* wp = AIN(4) + ((size_t)ml * 1024 + 128 * wid) * 6144 + n0 + lane;
                float acc[16];
#pragma unroll
                for (int i = 0; i < 16; ++i) acc[i] = 0.f;
#pragma unroll 8
                for (int kk = 0; kk < 128; ++kk) { const float w = __builtin_nontemporal_load(wp + (size_t)kk * 6144); const f32x4* cv = (const f32x4*)(cact + (128 * wid + kk) * 16);
#pragma unroll
                    for (int q = 0; q < 4; ++q) { const f32x4 c4 = cv[q]; acc[4 * q] += c4[0] * w; acc[4 * q + 1] += c4[1] * w; acc[4 * q + 2] += c4[2] * w; acc[4 * q + 3] += c4[3] * w; } }
#pragma unroll
                for (int i = 0; i < 16; ++i) part[(wid * 16 + i) * 64 + lane] = acc[i];
                __syncthreads();
                for (int o = tid; o < 1024; o += 512) { const int bb = o >> 6, ln = o & 63; float s = 0.f;
#pragma unroll
                    for (int w = 0; w < 8; ++w) s += part[(w * 16 + bb) * 64 + ln];
                    MOD[((size_t)ml * 16 + bb) * 6144 + n0 + ln] = s + AIN(5)[ml * 6144 + n0 + ln]; }
                __syncthreads();
            }
            for (int idx = bid * 512 + tid; idx < 8192 * 16; idx += G * 512) { const int s = idx >> 4, f = idx & 15;
                const float invf = exp2f(-(float)f * 0.8304820237218405f); const float ang = (float)s * invf;
                double rev = (double)ang * 0.15915494309189535; rev -= floor(rev); const float fr = (float)rev;
                ROPE[idx] = (f32x2){__builtin_amdgcn_cosf(fr), __builtin_amdgcn_sinf(fr)}; }
            { unsigned z_ = 0u; asm volatile("" : "+v"(z_));
              for (int i = bid * 512 + tid; i < 96 * 1024 / 8; i += G * 512) *(u32x4*)(Wdkv_t + (size_t)416 * 1024 + (size_t)i * 8) = (u32x4){z_, z_, z_, z_}; }
            {
                LAS float* scr = (LAS float*)((LAS unsigned char*)lds + wid * 16384);
                constexpr int I0 = 16 * 13, I1 = 4 * 48, I2 = 2 * 64, I3 = 16 * 32, I4 = 16 * 96, I5 = 16 * 32, I6 = 16 * 176, I7 = 44 * 32;
                constexpr int NIT = I0 + I1 + I2 + I3 + I4 + I5 + 2 * I6 + 2 * I7;
                for (int it = gw; it < NIT; it += ngw) {
                    int r = it;
                    if (r < I0) { transpose_item(AIN(10), 1024, 416, Wdkv_t, 64 * (r / 13), 32 * (r % 13), 32 * (r % 13), scr, lane); continue; } r -= I0;
                    if (r < I1) { transpose_item(AIN(13), 256, 1536, Wuq_t, 64 * (r / 48), 32 * (r % 48), 32 * (r % 48), scr, lane); continue; } r -= I1;
                    if (r < I2) { transpose_item(AIN(14), 128, 2048, Wukv_t, 64 * (r / 64), 32 * (r % 64), 32 * (r % 64), scr, lane); continue; } r -= I2;
                    if (r < I3) { transpose_item(AIN(15), 1024, 1024, Wo_t, 64 * (r / 32), 32 * (r % 32), 32 * (r % 32), scr, lane); continue; } r -= I3;
                    if (r < I4) { transpose_item(AIN(16), 1024, 3072, NAqkv_t, 64 * (r / 96), 32 * (r % 96), 32 * (r % 96), scr, lane); continue; } r -= I4;
                    if (r < I5) { transpose_item(AIN(18), 1024, 1024, NAo_t, 64 * (r / 32), 32 * (r % 32), 32 * (r % 32), scr, lane); continue; } r -= I5;
                    if (r < 2 * I6) { const int ll = r / I6; r -= ll * I6; const int n0 = 32 * (r % 176); const int jj = n0 < FF ? n0 : n0 - FF; const int drow = (jj >> 7) * 256 + (n0 < FF ? 0 : 128) + (jj & 127);
                        transpose_item(AIN(19) + (size_t)ll * 1024 * 5632, 1024, 5632, Wgu_t + (size_t)ll * 5632 * 1024, 64 * (r / 176), n0, drow, scr, lane); continue; } r -= 2 * I6;
                    { const int ll = r / I7; r -= ll * I7; transpose_item(AIN(20) + (size_t)ll * FF * 1024, FF, 1024, Wdn_t + (size_t)ll * 1024 * FF, 64 * (r / 32), 32 * (r % 32), 32 * (r % 32), scr, lane); }
                }
            }
        } break;
        case 1: if (PH_ON(1)) {
            RowP P{x_p, x_s, nullptr, nullptr, nullptr, nullptr, HN, AIN(6), MOD + 1 * 1024, MOD + 0 * 1024};
            rowpass<false, true, false, false>(P, gw, ngw, lane);
        } break;
        case 2: if (PH_ON(2)) {
            pg8::Gemm g{HN, Wdkv_t, T, NLAT, 1024}; pg8::StaticOrder S; S.init(T, NLAT, G, bid);
            pg8::EpiLat E{CQ, CKV, KR, AIN(11), AIN(12), ROPE, (LAS float*)((LAS unsigned char*)lds + 131072)};
            pg8::gemm_phase<pg8::EpiLat>((LAS unsigned char*)lds, g, S, E, tid);
        } break;
        case 3: break;
        case 4: case 5: case 7: case 10: case 12: if (PH_ON(5)) {
            pg8::Gemm g; pg8::EpiBf16S E; E.scale_cols = 0; E.scale0 = 1.f;
            if (kind == 4) { g = pg8::Gemm{CQ, Wuq_t, T, NQ, 256}; E.O = QB; E.ldc = NQ; E.scale_cols = NQ; E.scale0 = QSCALE_MLA; }
            else if (kind == 5) { g = pg8::Gemm{CKV, Wukv_t, T, NKV, 128}; E.O = KV; E.ldc = NKV; }
            else if (kind == 7) { g = pg8::Gemm{OB, l ? NAo_t : Wo_t, T, 1024, 1024}; E.O = HMIX; E.ldc = 1024; }
            else if (kind == 10) { g = pg8::Gemm{HID, Wdn_t + (size_t)l * 1024 * FF, T, 1024, FF}; E.O = HMIX; E.ldc = 1024; }
            else { g = pg8::Gemm{HN, NAqkv_t, T, 3072, 1024}; E.O = QKV; E.ldc = 3072; E.scale_cols = 1024; E.scale0 = QSCALE_NA; }
            pg8::StaticOrder S; S.init(T, g.N, G, bid);
            pg8::gemm_phase<pg8::EpiBf16S>((LAS unsigned char*)lds, g, S, E, tid);
        } break;
        case 6: if (PH_ON(6)) {
            mla::phase(QB, KV, KR, OB, ROPE, (char*)lds, tid, bid, G);
        } break;
        case 8: if (PH_ON(8)) {
            const float* md = MOD + (size_t)l * 16 * 6144;
            RowP P{l ? out : x_p, l ? out + (size_t)TP * DM : x_s, HMIX, AIN(7) + l * 1024, md + 2 * 1024, out, HN, AIN(8) + l * 1024, md + 4 * 1024, md + 3 * 1024};
            if (l == 0) rowpass<true, true, false, true>(P, gw, ngw, lane); else rowpass<true, true, true, true>(P, gw, ngw, lane);
        } break;
        case 9: if (PH_ON(9)) {
            pg8::Gemm g{HN, Wgu_t + (size_t)l * 5632 * 1024, T, 5632, 1024}; pg8::StaticOrder S; S.init(T, 5632, G, bid);
            pg8::EpiSwiGLU E{HID};
            pg8::gemm_phase<pg8::EpiSwiGLU>((LAS unsigned char*)lds, g, S, E, tid);
        } break;
        case 11: if (PH_ON(11)) {
            const float* md = MOD + (size_t)l * 16 * 6144; const float* md1 = MOD + (size_t)16 * 6144;
            RowP P{out, out + (size_t)TP * DM, HMIX, AIN(9) + l * 1024, md + 5 * 1024, out, HN, AIN(6) + 1024, md1 + 1 * 1024, md1 + 0 * 1024};
            if (l == 0) rowpass<true, true, true, true>(P, gw, ngw, lane); else rowpass<true, false, true, false>(P, gw, ngw, lane);
        } break;
        case 13: if (PH_ON(13)) {
            na::phase(QKV, OB, AIN(17), (char*)lds, tid, bid, G);
        } break;
        default: break;
        }
#if MK_MULTI
#define SEAM() do { } while (0)
#else
#define SEAM() do { if (ph_lo < 0) grid.sync(); XcdBarrier xb_ = xbar; asm volatile("" : "+s"(xb_.bar)); xcd_barrier(xb_); } while (0)
#endif
        if (REP_MASK != 0 && ((REP_MASK >> ph) & 1) && !rep_done) { rep_done = 1; --ph; SEAM(); continue; }
        rep_done = 0;
        if (ph + 1 < ph_hi && ph != 4 && ph != 3) { SEAM(); for (int e = 0; e < EXTRA_SYNC; ++e) SEAM(); }
    }
}

extern "C" void kernel_launch(void* const* d_in, const int* in_sizes, int n_in, void* d_out, int out_size, void* d_ws, size_t ws_size, hipStream_t stream) {
    static int grid = 0;
    if (grid == 0) {
        if (n_in != 21 || out_size != T * DM || ws_size < WS_END) { fprintf(stderr, "kernel_launch: unexpected shapes: n_in %d out %d ws %zu\n", n_in, out_size, ws_size); grid = -1; return; }
        int dev = 0, cus = 0, per_cu = 0;
        hipGetDevice(&dev); hipDeviceGetAttribute(&cus, hipDeviceAttributeMultiprocessorCount, dev);
        if (hipFuncSetAttribute((const void*)fwd_kernel, hipFuncAttributeMaxDynamicSharedMemorySize, LDS_BYTES) != hipSuccess) { fprintf(stderr, "kernel_launch: hipFuncSetAttribute failed\n"); grid = -1; return; }
        hipOccupancyMaxActiveBlocksPerMultiprocessor(&per_cu, (const void*)fwd_kernel, 512, LDS_BYTES);
        per_cu = 1;
        grid = cus * per_cu;
        fprintf(stderr, "kernel_launch: cus %d per_cu %d grid %d\n", cus, per_cu, grid);
    }
    if (grid < 0) return;
    Args a{};
    for (int i = 0; i < 21; ++i) a.in[i] = (const float*)d_in[i];
    a.out = (float*)d_out; a.ws = (unsigned char*)d_ws;
#if MK_MULTI
    for (int ph = 0; ph < N_PHASES; ++ph) {
        a.ph_lo = ph; a.ph_hi = ph + 1;
        hipLaunchKernelGGL(fwd_kernel, dim3(grid), dim3(512), LDS_BYTES, stream, a);
    }
#else
    a.ph_lo = 0; a.ph_hi = N_PHASES;
    if (hipMemsetAsync((char*)d_ws + WS_BAR, 0, BAR_BYTES, stream) != hipSuccess) { fprintf(stderr, "kernel_launch: memset failed\n"); return; }
    void* kargs[] = {&a};
    hipError_t e = hipLaunchCooperativeKernel((const void*)fwd_kernel, dim3(grid), dim3(512), kargs, LDS_BYTES, stream);
    if (e != hipSuccess) fprintf(stderr, "kernel_launch: cooperative launch failed: %s (grid %d)\n", hipGetErrorString(e), grid);
#endif
}
```
